# Optimizing an MI355X kernel written in HIP

```python
import math
import jax, jax.numpy as jnp
from jax import lax
import numpy as np

D_MODEL = 1024
BATCH = 4
SEQ = 4096
DEPTH = 1

GLA_HEADS = 4
GLA_DK = D_MODEL // 2 // GLA_HEADS
GLA_DV = D_MODEL // GLA_HEADS
GLA_LOWRANK = 16
GLA_TAU = 16.0
GLA_CHUNK = 64
FNET_GROUPS = 4
FNET_GW = D_MODEL // 8
MEM_LEN = 256
MEM_HEADS = 4
MEM_HD = D_MODEL // 8
N_BRANCH = 3
N_EXPERTS = 32
TOP_K = 4
D_FF = D_MODEL
SWIGLU_LIMIT = 7.0
SWIGLU_ALPHA = 1.702
MOE_BLOCK = 256
LN_EPS = 1e-5
RMS_EPS = 1e-6
DN_ALPHA = (2.0 * DEPTH) ** 0.25
DN_BETA = (8.0 * DEPTH) ** -0.25

QK_W = GLA_HEADS * GLA_DK
V_W = GLA_HEADS * GLA_DV
R_W = V_W
FN_W = FNET_GROUPS * FNET_GW
MQ_W = MEM_HEADS * MEM_HD
GATE_W = N_BRANCH * D_MODEL
IN_SIZES = (QK_W, QK_W, V_W, R_W, GLA_LOWRANK, GLA_LOWRANK, FN_W, MQ_W, GATE_W)
IN_WIDTH = sum(IN_SIZES)

kernel_name = "hybrid_gla_fnet_memxattn_moe_encoder"


def layer_norm(x, g, b):
    xf = x.astype(jnp.float32)
    mu = jnp.mean(xf, axis=-1, keepdims=True)
    var = jnp.mean(jnp.square(xf - mu), axis=-1, keepdims=True)
    return ((xf - mu) * lax.rsqrt(var + LN_EPS) * g + b).astype(x.dtype)


def gla_chunked(q, k, v, log_a):
    B, S, H, DK = q.shape
    DV = v.shape[-1]
    C = GLA_CHUNK
    N = S // C

    def chunk(t):
        return t.astype(jnp.float32).reshape(B, N, C, H, t.shape[-1]).transpose(1, 0, 3, 2, 4)

    qc, kc, vc, ac = chunk(q), chunk(k), chunk(v), chunk(log_a)
    bcum = jnp.cumsum(ac, axis=-2)
    blast = bcum[..., -1:, :]
    q_in = qc * jnp.exp(bcum)
    k_in = kc * jnp.exp(-bcum)
    k_st = kc * jnp.exp(blast - bcum)
    mask = jnp.tril(jnp.ones((C, C), dtype=bool))
    att = jnp.where(mask, jnp.einsum('nbhik,nbhjk->nbhij', q_in, k_in), 0.0)
    o_intra = jnp.einsum('nbhij,nbhjv->nbhiv', att, vc)

    def step(state, inp):
        q_i, k_s, v_i, dec = inp
        o = jnp.einsum('bhik,bhkv->bhiv', q_i, state)
        state = state * jnp.exp(dec[..., 0, :])[..., None] + jnp.einsum('bhjk,bhjv->bhkv', k_s, v_i)
        return state, o

    state0 = jnp.zeros((B, H, DK, DV), jnp.float32)
    _, o_inter = lax.scan(step, state0, (q_in, k_st, vc, blast))
    o = o_intra + o_inter
    return o.transpose(1, 0, 3, 2, 4).reshape(B, S, H, DV)


def mixer_branches(u, mem_n, w_in, b_in, w_decay_f, b_decay_f, w_decay_b, b_decay_b,
                   gla_norm_g, w_br_gla, w_br_fnet, w_br_mem, w_mem_kv, w_out, b_out):
    B, S, D = u.shape
    dt = u.dtype
    proj = u @ w_in + b_in
    splits = np.cumsum(IN_SIZES)[:-1].tolist()
    q, k, v, r, lr_f, lr_b, fn, mq, gates = jnp.split(proj, splits, axis=-1)

    def heads(t, d):
        return t.reshape(B, S, GLA_HEADS, d)
    qh = heads(q, GLA_DK) * (GLA_DK ** -0.5)
    kh = heads(k, GLA_DK)
    vh = heads(v, GLA_DV)
    la_f = heads(jax.nn.log_sigmoid((lr_f @ w_decay_f + b_decay_f).astype(jnp.float32)) / GLA_TAU, GLA_DK)
    la_b = heads(jax.nn.log_sigmoid((lr_b @ w_decay_b + b_decay_b).astype(jnp.float32)) / GLA_TAU, GLA_DK)
    flip = lambda t: jnp.flip(t, axis=1)
    o_f = gla_chunked(qh, kh, vh, la_f)
    o_b = flip(gla_chunked(flip(qh), flip(kh), flip(vh), flip(la_b)))
    o = o_f + o_b
    o = o * lax.rsqrt(jnp.mean(jnp.square(o), axis=-1, keepdims=True) + RMS_EPS) * gla_norm_g
    o = (o * jax.nn.silu(heads(r, GLA_DV).astype(jnp.float32))).astype(dt).reshape(B, S, V_W)
    y_gla = o @ w_br_gla

    f = fn.reshape(B, S, FNET_GROUPS, FNET_GW).astype(jnp.float32)
    f = jnp.fft.fft2(f, axes=(1, 3), norm='ortho').real
    y_fnet = f.astype(dt).reshape(B, S, FN_W) @ w_br_fnet

    kv = mem_n @ w_mem_kv
    mk, mv = jnp.split(kv, 2, axis=-1)
    M = mem_n.shape[1]
    qm = mq.reshape(B, S, MEM_HEADS, MEM_HD)
    mk = mk.reshape(B, M, MEM_HEADS, MEM_HD)
    mv = mv.reshape(B, M, MEM_HEADS, MEM_HD)
    s = jnp.einsum('bshd,bmhd->bhsm', qm, mk).astype(jnp.float32) * (MEM_HD ** -0.5)
    p = jax.nn.softmax(s, axis=-1).astype(dt)
    om = jnp.einsum('bhsm,bmhd->bshd', p, mv).reshape(B, S, MQ_W)
    y_mem = om @ w_br_mem

    g = jax.nn.sigmoid(gates.astype(jnp.float32)).reshape(B, S, N_BRANCH, D)
    merged = (g[:, :, 0] * y_gla.astype(jnp.float32)
              + g[:, :, 1] * y_fnet.astype(jnp.float32)
              + g[:, :, 2] * y_mem.astype(jnp.float32)).astype(dt)
    return merged @ w_out + b_out


def moe_ffn(h, w_router, b_router, w_gu, b_gu, w_down, b_down):
    B, S, D = h.shape
    T = B * S
    A = T * TOP_K
    hf = h.reshape(T, D)
    logits = (hf @ w_router + b_router).astype(jnp.float32)
    top_val, top_idx = lax.top_k(logits, TOP_K)
    top_w = jax.nn.softmax(top_val, axis=-1)
    flat_e = top_idx.reshape(A).astype(jnp.int32)
    flat_tok = jnp.repeat(jnp.arange(T, dtype=jnp.int32), TOP_K)
    flat_w = top_w.reshape(A)
    order = jnp.argsort(flat_e)
    sorted_e = flat_e[order]
    counts = jnp.bincount(flat_e, length=N_EXPERTS)
    start = jnp.cumsum(counts) - counts
    padded = (counts + MOE_BLOCK - 1) // MOE_BLOCK * MOE_BLOCK
    pad_end = jnp.cumsum(padded)
    pad_start = pad_end - padded
    dest = pad_start[sorted_e] + (jnp.arange(A, dtype=jnp.int32) - start[sorted_e])
    n_blocks = (A + N_EXPERTS * (MOE_BLOCK - 1) + MOE_BLOCK - 1) // MOE_BLOCK
    P = n_blocks * MOE_BLOCK
    buf_tok = jnp.zeros((P,), jnp.int32).at[dest].set(flat_tok[order])
    buf_w = jnp.zeros((P,), jnp.float32).at[dest].set(flat_w[order])
    block_e = jnp.minimum(
        jnp.searchsorted(pad_end, jnp.arange(n_blocks, dtype=pad_end.dtype) * MOE_BLOCK, side='right'),
        N_EXPERTS - 1)

    def block_fn(inp):
        tok, wgt, e = inp
        xb = hf[tok]
        gu = xb @ w_gu[e] + b_gu[e]
        gate, up = jnp.split(gu, 2, axis=-1)
        gate = jnp.minimum(gate, SWIGLU_LIMIT)
        up = jnp.clip(up, -SWIGLU_LIMIT, SWIGLU_LIMIT)
        act = (up + 1.0) * (gate * jax.nn.sigmoid(SWIGLU_ALPHA * gate))
        out = act @ w_down[e] + b_down[e]
        return out * wgt[:, None].astype(out.dtype)

    outs = lax.map(block_fn, (buf_tok.reshape(n_blocks, MOE_BLOCK),
                              buf_w.reshape(n_blocks, MOE_BLOCK), block_e))
    y = jnp.zeros((T, D), h.dtype).at[buf_tok].add(outs.reshape(P, D).astype(h.dtype))
    return y.reshape(B, S, D)


def setup_inputs(seed: int = 0) -> dict:
    key = jax.random.key(seed)
    keys = jax.random.split(key, 40)
    ctr = [0]

    def nrm(shape, scale):
        k_ = keys[ctr[0]]
        ctr[0] += 1
        return jax.random.normal(k_, shape, jnp.float32) * scale

    L, D = DEPTH, D_MODEL
    x = nrm((BATCH, SEQ, D), 1.0)
    mem = nrm((BATCH, MEM_LEN, D), 1.0)
    ln_in_g = 1.0 + nrm((D,), 0.02)
    ln_in_b = nrm((D,), 0.01)
    ln_mem_g = 1.0 + nrm((D,), 0.02)
    ln_mem_b = nrm((D,), 0.01)
    col_scale = jnp.concatenate([jnp.ones((2 * QK_W,), jnp.float32),
                                 jnp.full((V_W,), DN_BETA, jnp.float32),
                                 jnp.ones((IN_WIDTH - 2 * QK_W - V_W,), jnp.float32)])
    w_in = nrm((L, D, IN_WIDTH), D ** -0.5) * col_scale
    b_in = nrm((L, IN_WIDTH), 0.01)
    w_decay_f = nrm((L, GLA_LOWRANK, QK_W), GLA_LOWRANK ** -0.5)
    b_decay_f = nrm((L, QK_W), 0.1)
    w_decay_b = nrm((L, GLA_LOWRANK, QK_W), GLA_LOWRANK ** -0.5)
    b_decay_b = nrm((L, QK_W), 0.1)
    gla_norm_g = 1.0 + nrm((L, GLA_DV), 0.02)
    w_br_gla = nrm((L, V_W, D), V_W ** -0.5)
    w_br_fnet = nrm((L, FN_W, D), FN_W ** -0.5)
    w_br_mem = nrm((L, MQ_W, D), MQ_W ** -0.5)
    kv_scale = jnp.concatenate([jnp.ones((MQ_W,), jnp.float32), jnp.full((MQ_W,), DN_BETA, jnp.float32)])
    w_mem_kv = nrm((L, D, 2 * MQ_W), D ** -0.5) * kv_scale
    w_out = nrm((L, D, D), D ** -0.5) * DN_BETA
    b_out = nrm((L, D), 0.01)
    ln1_g = 1.0 + nrm((L, D), 0.02)
    ln1_b = nrm((L, D), 0.01)
    w_router = nrm((L, D, N_EXPERTS), D ** -0.5)
    b_router = nrm((L, N_EXPERTS), 0.01)
    w_gu = nrm((L, N_EXPERTS, D, 2 * D_FF), D ** -0.5)
    b_gu = nrm((L, N_EXPERTS, 2 * D_FF), 0.01)
    w_down = nrm((L, N_EXPERTS, D_FF, D), D_FF ** -0.5) * DN_BETA
    b_down = nrm((L, N_EXPERTS, D), 0.01)
    ln2_g = 1.0 + nrm((L, D), 0.02)
    ln2_b = nrm((L, D), 0.01)
    return {"x": x, "mem": mem, "ln_in_g": ln_in_g, "ln_in_b": ln_in_b,
            "ln_mem_g": ln_mem_g, "ln_mem_b": ln_mem_b, "w_in": w_in, "b_in": b_in,
            "w_decay_f": w_decay_f, "b_decay_f": b_decay_f, "w_decay_b": w_decay_b,
            "b_decay_b": b_decay_b, "gla_norm_g": gla_norm_g, "w_br_gla": w_br_gla,
            "w_br_fnet": w_br_fnet, "w_br_mem": w_br_mem, "w_mem_kv": w_mem_kv,
            "w_out": w_out, "b_out": b_out, "ln1_g": ln1_g, "ln1_b": ln1_b,
            "w_router": w_router, "b_router": b_router, "w_gu": w_gu, "b_gu": b_gu,
            "w_down": w_down, "b_down": b_down, "ln2_g": ln2_g, "ln2_b": ln2_b}


def reference(x, mem, ln_in_g, ln_in_b, ln_mem_g, ln_mem_b, w_in, b_in,
              w_decay_f, b_decay_f, w_decay_b, b_decay_b, gla_norm_g, w_br_gla,
              w_br_fnet, w_br_mem, w_mem_kv, w_out, b_out, ln1_g, ln1_b,
              w_router, b_router, w_gu, b_gu, w_down, b_down, ln2_g, ln2_b):
    h = layer_norm(x, ln_in_g, ln_in_b)
    mem_n = layer_norm(mem, ln_mem_g, ln_mem_b)
    for l in range(DEPTH):
        mix = mixer_branches(h, mem_n, w_in[l], b_in[l], w_decay_f[l], b_decay_f[l],
                             w_decay_b[l], b_decay_b[l], gla_norm_g[l], w_br_gla[l],
                             w_br_fnet[l], w_br_mem[l], w_mem_kv[l], w_out[l], b_out[l])
        h = layer_norm(DN_ALPHA * h + mix, ln1_g[l], ln1_b[l])
        ff = moe_ffn(h, w_router[l], b_router[l], w_gu[l], b_gu[l], w_down[l], b_down[l])
        h = layer_norm(DN_ALPHA * h + ff, ln2_g[l], ln2_b[l])
    return h
```

```cpp
#include <hip/hip_runtime.h>
#include <cstdio>
#include <cstdint>

#ifndef MK_PER_PHASE
#define MK_PER_PHASE 0
#endif

namespace pg8 {
#define PG8_LAS __attribute__((address_space(3)))
typedef unsigned short bf16_t;
typedef short bf16x8 __attribute__((ext_vector_type(8)));
typedef float f32x4 __attribute__((ext_vector_type(4)));
typedef float f32x2 __attribute__((ext_vector_type(2)));
typedef unsigned u32x4 __attribute__((ext_vector_type(4)));
typedef unsigned u32x2 __attribute__((ext_vector_type(2)));
constexpr int BM = 256, BK = 64, HALF = 128, HTB = HALF * BK * 2, STAGE_BYTES = 8 * HTB, NXCD = 8, WGM = 8;

__host__ __device__ __forceinline__ int lds_byte(int r, int c) { const int st = (r >> 4) * 2 + (c >> 5), rr = r & 15, cc = c & 31, ob = rr * 64 + cc * 2; return st * 1024 + (ob ^ (((ob >> 9) & 1) << 5)); }
__host__ __device__ __forceinline__ void stage_rc(int b, int& R, int& C) { const int st = b / 1024, sb = b % 1024, swz = sb ^ (((sb >> 9) & 1) << 5); R = (st >> 1) * 16 + swz / 64; C = (st & 1) * 32 + (swz % 64) / 2; }
__host__ __device__ __forceinline__ int perm32(int rho) { const int n = rho >> 4, i = rho & 15; return 8 * (i >> 2) + 4 * n + (i & 3); }

struct Unit { int pm, pn, z; };
struct Gemm { const bf16_t* A; const bf16_t* Bt; int lda, ldb, K; };

struct StaticOrder {
    static constexpr bool GATHER = false;
    int nM, nN, nwg, G, c, nz; size_t az, bz;
    int lda, ldb;
    __device__ void init(int M, int N, int G_, int c_, int lda_, int ldb_, int nz_ = 1, size_t az_ = 0, size_t bz_ = 0) { nM = M / BM; nN = N / BM; nwg = nM * nN; G = G_; c = c_; nz = nz_; az = az_; bz = bz_; lda = lda_; ldb = ldb_; }
    __device__ bool next(int i, Unit& u) const {
        const long L = (long)i * G + c; if (c < 0 || L >= (long)nwg * nz) return false;
        int wgid = (int)(L % nwg); u.z = (int)(L / nwg);
        { const int q = nwg / NXCD, r = nwg % NXCD, xcd = wgid % NXCD, off = wgid / NXCD; wgid = (xcd < r ? xcd * (q + 1) : r * (q + 1) + (xcd - r) * q) + off; }
        const int nig = WGM * nN, gid = wgid / nig, fm = gid * WGM, gsz = (nM - fm) < WGM ? (nM - fm) : WGM;
        u.pm = fm + ((wgid % nig) % gsz); u.pn = (wgid % nig) / gsz; return true;
    }
    __device__ __forceinline__ size_t a_off(const Unit& u) const { return (size_t)u.z * az + (size_t)u.pm * BM * lda * 2; }
    __device__ __forceinline__ size_t b_off(const Unit& u) const { return (size_t)u.z * bz + (size_t)u.pn * BM * ldb * 2; }
    __device__ __forceinline__ unsigned gather_row(const Unit&, int) const { return 0u; }
};

__device__ __forceinline__ unsigned cvt_pk_bf16(float lo, float hi) { unsigned r; asm volatile("v_cvt_pk_bf16_f32 %0, %1, %2" : "=v"(r) : "v"(lo), "v"(hi)); return r; }

template <class Epi, class Sched>
__device__ __forceinline__ void gemm_phase(PG8_LAS unsigned char* lds, const Gemm g, const Sched& S, const Epi& E) {
    constexpr bool GA = Sched::GATHER;
    const int tid = threadIdx.x, wid = __builtin_amdgcn_readfirstlane(tid >> 6), lane = tid & 63, wr = wid >> 2, wc = wid & 3, fr = lane & 15, fq = lane >> 4;
    const int K = g.K, nt = K / BK;
    unsigned voffA[2], voffB[2]; int RA[2], CA[2];
#pragma unroll
    for (int i = 0; i < 2; ++i) { int R, C; stage_rc(tid * 16 + i * 8192, R, C); const int Rb = Epi::PERM ? ((R & ~31) + perm32(R & 31)) : R;
        RA[i] = R; CA[i] = C; voffA[i] = (unsigned)(R * g.lda + C) * 2u; voffB[i] = (unsigned)(Rb * g.ldb + C) * 2u; }
    const size_t kstep = (size_t)(BK * 2);
    const size_t hstepA = GA ? 0 : (size_t)HALF * g.lda * 2, hstepB = (size_t)HALF * g.ldb * 2;
    const unsigned ldsw = (unsigned)wid * 1024u;
    const int aoff = lds_byte(wr * 64 + fr, fq * 8), boff = lds_byte(wc * 32 + fr, fq * 8);
    unsigned vgc[2][2], vgn[2][2];
#define PG8_SA(b, h) (((b) * 2 + (h)) * HTB)
#define PG8_SB(b, h) ((4 + (b) * 2 + (h)) * HTB)
#define PG8_STAGE(bufoff, gbase, voff) do { _Pragma("unroll") for (int _i = 0; _i < 2; ++_i) \
        __builtin_amdgcn_global_load_lds((const unsigned*)((const char*)(gbase) + (voff)[_i]), (PG8_LAS unsigned*)(lds + (bufoff) + ldsw + _i * 8192), 16, 0, 0); } while (0)
#define PG8_STAGE_A(bufoff, gbase, h, nx) do { if constexpr (GA) { unsigned _v[2]; _v[0] = (nx) ? vgn[h][0] : vgc[h][0]; _v[1] = (nx) ? vgn[h][1] : vgc[h][1]; PG8_STAGE(bufoff, gbase, _v); } \
        else { PG8_STAGE(bufoff, (gbase) + (h) * hstepA, voffA); } } while (0)
#define PG8_LDA(dst, b, h) do { _Pragma("unroll") for (int m = 0; m < 4; ++m) _Pragma("unroll") for (int k = 0; k < 2; ++k) dst[m][k] = *(const PG8_LAS bf16x8*)(lds + PG8_SA(b, h) + aoff + m * 2048 + k * 1024); } while (0)
#define PG8_LDB(dst, b, h) do { _Pragma("unroll") for (int n = 0; n < 2; ++n) _Pragma("unroll") for (int k = 0; k < 2; ++k) dst[n][k] = *(const PG8_LAS bf16x8*)(lds + PG8_SB(b, h) + boff + n * 2048 + k * 1024); } while (0)
#define PG8_MMA(ai, bj, At, Bt) do { __builtin_amdgcn_s_setprio(1); _Pragma("unroll") for (int m = 0; m < 4; ++m) _Pragma("unroll") for (int n = 0; n < 2; ++n) _Pragma("unroll") for (int k = 0; k < 2; ++k) \
        acc[ai][bj][m][n] = __builtin_amdgcn_mfma_f32_16x16x32_bf16(Bt[n][k], At[m][k], acc[ai][bj][m][n], 0, 0, 0); __builtin_amdgcn_s_setprio(0); } while (0)
#define PG8_WAIT_V(n) asm volatile("s_waitcnt vmcnt(" #n ")" ::: "memory")
#define PG8_WAIT_L(n) asm volatile("s_waitcnt lgkmcnt(" #n ")" ::: "memory")
#define PG8_BAR __builtin_amdgcn_s_barrier()
#define PG8_SCHED __builtin_amdgcn_sched_barrier(0)
    Unit cur, nxt; int ui = 0;
    if (!S.next(0, cur)) return;
    f32x4 acc[2][2][4][2];
#pragma unroll
    for (int a = 0; a < 2; ++a)
#pragma unroll
        for (int b = 0; b < 2; ++b)
#pragma unroll
            for (int m = 0; m < 4; ++m)
#pragma unroll
                for (int n = 0; n < 2; ++n) acc[a][b][m][n] = (f32x4){0.f, 0.f, 0.f, 0.f};
    bf16x8 At[4][2], B0[2][2], B1[2][2];
    const char* cA = (const char*)g.A + (GA ? 0 : S.a_off(cur)); const char* cB = (const char*)g.Bt + S.b_off(cur);
    if constexpr (GA) {
#pragma unroll
        for (int h = 0; h < 2; ++h)
#pragma unroll
            for (int i = 0; i < 2; ++i) { vgc[h][i] = S.gather_row(cur, h * HALF + RA[i]) + (unsigned)CA[i] * 2u; vgn[h][i] = vgc[h][i]; }
    }
    PG8_STAGE(PG8_SB(0, 0), cB, voffB); PG8_STAGE(PG8_SB(0, 1), cB + hstepB, voffB); PG8_STAGE_A(PG8_SA(0, 0), cA, 0, false); PG8_STAGE_A(PG8_SA(0, 1), cA, 1, false);
    if (wr == 1) PG8_BAR;
    PG8_WAIT_V(2); PG8_BAR;
    PG8_STAGE(PG8_SB(1, 0), cB + kstep, voffB); PG8_STAGE_A(PG8_SA(1, 0), cA + kstep, 0, false); PG8_STAGE(PG8_SB(1, 1), cB + hstepB + kstep, voffB);
    PG8_WAIT_V(6); PG8_BAR;
    for (;;) {
        const bool has_next = S.next(ui + 1, nxt);
        const char* nA = has_next ? (const char*)g.A + (GA ? 0 : S.a_off(nxt)) : cA; const char* nB = has_next ? (const char*)g.Bt + S.b_off(nxt) : cB;
        if constexpr (GA) { if (has_next) {
#pragma unroll
            for (int h = 0; h < 2; ++h)
#pragma unroll
                for (int i = 0; i < 2; ++i) vgn[h][i] = S.gather_row(nxt, h * HALF + RA[i]) + (unsigned)CA[i] * 2u; } }
        for (int t = 0; t < nt; t += 2) {
            const bool last = (t == nt - 2);
            const char* a1 = cA + (size_t)(t + 1) * kstep;
            const char* a2 = last ? nA : cA + (size_t)(t + 2) * kstep; const char* b2 = last ? nB : cB + (size_t)(t + 2) * kstep;
            const char* a3 = a2 + kstep; const char* b3 = b2 + kstep;
            PG8_LDB(B0, 0, 0); PG8_LDB(B1, 0, 1); PG8_SCHED; PG8_LDA(At, 0, 0); PG8_STAGE_A(PG8_SA(1, 1), a1, 1, false);
            PG8_WAIT_V(8); PG8_WAIT_L(0); PG8_BAR; PG8_MMA(0, 0, At, B0); PG8_MMA(0, 1, At, B1); PG8_BAR; PG8_SCHED;
            PG8_LDA(At, 0, 1); PG8_STAGE(PG8_SB(0, 0), b2, voffB); PG8_STAGE(PG8_SB(0, 1), b2 + hstepB, voffB); PG8_STAGE_A(PG8_SA(0, 0), a2, 0, last);
            PG8_WAIT_V(8); PG8_WAIT_L(0); PG8_BAR; PG8_MMA(1, 0, At, B0); PG8_MMA(1, 1, At, B1); PG8_BAR; PG8_SCHED;
            PG8_LDB(B0, 1, 0); PG8_LDB(B1, 1, 1); PG8_SCHED; PG8_LDA(At, 1, 0); PG8_STAGE_A(PG8_SA(0, 1), a2, 1, last);
            PG8_WAIT_V(8); PG8_WAIT_L(0); PG8_BAR; PG8_MMA(0, 0, At, B0); PG8_MMA(0, 1, At, B1); PG8_BAR; PG8_SCHED;
            PG8_LDA(At, 1, 1); PG8_STAGE(PG8_SB(1, 0), b3, voffB); PG8_STAGE(PG8_SB(1, 1), b3 + hstepB, voffB); PG8_STAGE_A(PG8_SA(1, 0), a3, 0, last);
            PG8_WAIT_V(8); PG8_WAIT_L(0); PG8_BAR; PG8_MMA(1, 0, At, B0); PG8_MMA(1, 1, At, B1); PG8_BAR; PG8_SCHED;
        }
        if (wr == 0) PG8_BAR;
        E(acc, cur, wr, wc, fr, fq);
        if (!has_next) break;
#pragma unroll
        for (int a = 0; a < 2; ++a)
#pragma unroll
            for (int b = 0; b < 2; ++b)
#pragma unroll
                for (int m = 0; m < 4; ++m)
#pragma unroll
                    for (int n = 0; n < 2; ++n) acc[a][b][m][n] = (f32x4){0.f, 0.f, 0.f, 0.f};
        cur = nxt; cA = nA; cB = nB; ++ui;
        if constexpr (GA) {
#pragma unroll
            for (int h = 0; h < 2; ++h)
#pragma unroll
                for (int i = 0; i < 2; ++i) vgc[h][i] = vgn[h][i]; }
        if (wr == 1) PG8_BAR;
    }
    PG8_WAIT_V(0);
    PG8_BAR;
#undef PG8_SA
#undef PG8_SB
#undef PG8_STAGE
#undef PG8_STAGE_A
#undef PG8_LDA
#undef PG8_LDB
#undef PG8_MMA
#undef PG8_WAIT_V
#undef PG8_WAIT_L
#undef PG8_BAR
#undef PG8_SCHED
}
}

constexpr int NWAVES = 8;
constexpr int T = 16384, D = 1024, NB = 4, SEQ = 4096, NP = 6912, MEM = 256;
constexpr int Q_OFF = 0, K_OFF = 512, V_OFF = 1024, R_OFF = 2048, MQ_OFF = 3072, G_OFF = 3584, LR_OFF = 6656;
constexpr int IN_W = 7200, LR_SRC = 3072, FN_SRC = 3104, MQ_SRC = 3616, G_SRC = 4128;
constexpr int NE = 32, DFF = 1024, ACT_ROWS = 73728;
constexpr float LN_EPS = 1e-5f, RMS_EPS = 1e-6f;
constexpr float DN_ALPHA = 1.18920711500272f;
constexpr int N_PHASES = 11;

constexpr size_t MiB = 1u << 20;
constexpr size_t WS_CTL = 0, CTL_ZERO_BYTES = 1 * MiB;
constexpr size_t WS_WIN = 1 * MiB;
constexpr size_t WS_WZ = 15 * MiB;
constexpr size_t WS_WKV = 17 * MiB;
constexpr size_t WS_WGLA = 19 * MiB;
constexpr size_t WS_WFN = 21 * MiB;
constexpr size_t WS_WMEM = 22 * MiB;
constexpr size_t WS_WOUT = 23 * MiB;
constexpr size_t WS_WRT = 25 * MiB;
constexpr size_t WS_BIN = WS_WRT + 65536;
constexpr size_t WS_BZ = WS_BIN + 32768;
constexpr size_t WS_BGU = WS_BZ + 4096;
constexpr size_t WS_WGU = 26 * MiB;
constexpr size_t WS_WDN = 154 * MiB;
constexpr size_t WS_H = 218 * MiB;
constexpr size_t WS_HB = 282 * MiB;
constexpr size_t WS_MEMN = 314 * MiB;
constexpr size_t WS_KV = 316 * MiB;
constexpr size_t WS_RT = 318 * MiB;
constexpr size_t WS_TOPW = WS_RT + 2 * MiB;
constexpr size_t WS_PROJ = 321 * MiB;
constexpr size_t WS_ZT = 537 * MiB;
constexpr size_t WS_DFT = 569 * MiB;
constexpr size_t WS_ACT = 321 * MiB;
constexpr size_t WS_YB = 465 * MiB;
constexpr size_t WS_OF = 633 * MiB;
constexpr size_t WS_OB = 697 * MiB;
constexpr size_t WS_OG = 761 * MiB;
constexpr size_t WS_F = 793 * MiB;
constexpr size_t WS_OM = 809 * MiB;
constexpr size_t WS_MG = 825 * MiB;
constexpr size_t WS_MGB = 889 * MiB;
constexpr size_t WS_END = 921 * MiB;
constexpr int CW_TMO = 0, CW_BAR = 4096, CW_CNT = 16384;

constexpr int RING_BYTES = 131072, LDSCTL_OFF = RING_BYTES, MISC_OFF = LDSCTL_OFF + 1024, LDS_BYTES = 147456;

#define GAS __attribute__((address_space(1)))
#define LAS __attribute__((address_space(3)))
typedef unsigned short bf16;
typedef unsigned v4u __attribute__((ext_vector_type(4)));
typedef unsigned v2u __attribute__((ext_vector_type(2)));
typedef float f32x4 __attribute__((ext_vector_type(4)));
typedef short bf16x8 __attribute__((ext_vector_type(8)));
typedef GAS unsigned gu32;
#define RLX_AGENT __ATOMIC_RELAXED, __HIP_MEMORY_SCOPE_AGENT
#define LDS_WAIT() asm volatile("s_waitcnt lgkmcnt(0)" ::: "memory")
#define VM_WAIT() asm volatile("s_waitcnt vmcnt(0)" ::: "memory")
__device__ __forceinline__ unsigned f2bf(float f) { unsigned u = __builtin_bit_cast(unsigned, f); return (u + 0x7fffu + ((u >> 16) & 1u)) >> 16; }
__device__ __forceinline__ unsigned pk2(float lo, float hi) { return f2bf(lo) | (f2bf(hi) << 16); }
__device__ __forceinline__ float bf2f(unsigned b) { return __builtin_bit_cast(float, b << 16); }
__device__ __forceinline__ float bflo(unsigned w) { return __builtin_bit_cast(float, w << 16); }
__device__ __forceinline__ float bfhi(unsigned w) { return __builtin_bit_cast(float, w & 0xffff0000u); }

#define XB_TMO      128
#define XB_XCNT(j)  (256  + 64 * (j))
#define XB_XSUB(j)  (1280 + 64 * (j))
#define XB_XGEN(j)  (2304 + 64 * (j))
#define XB_TOP      3328
#define XB_TOPGEN   3392
#define XCD_BAR_WORDS 3456
#define XB_SPIN_CAP (1u << 22)
__device__ __forceinline__ unsigned xb_ld(unsigned* p)              { return __hip_atomic_load(p, __ATOMIC_RELAXED, __HIP_MEMORY_SCOPE_AGENT); }
__device__ __forceinline__ unsigned xb_add(unsigned* p, unsigned v) { return __hip_atomic_fetch_add(p, v, __ATOMIC_RELAXED, __HIP_MEMORY_SCOPE_AGENT); }
__device__ __forceinline__ unsigned xb_xcc_id() { return (unsigned)__builtin_amdgcn_s_getreg((3 << 11) | 20) & 0xFu; }
#define XB_SPIN(cond, bar) do { unsigned _sp = 0; while (cond) { __builtin_amdgcn_s_sleep(1); \
    if ((++_sp & 255u) == 0u) { if (xb_ld(&(bar)[XB_TMO])) break; if (_sp > XB_SPIN_CAP) { atomicAdd(&(bar)[XB_TMO], 1u); break; } } } } while (0)
struct XcdBarrier { unsigned* bar; unsigned x; volatile LAS unsigned* st; };
__device__ __forceinline__ XcdBarrier xcd_barrier_post(unsigned* bar, volatile LAS unsigned* st) {
    XcdBarrier b; b.bar = bar; b.x = xb_xcc_id(); b.st = st;
    if (threadIdx.x == 0) (void)xb_add(&bar[XB_XCNT(b.x)], 1u);
    return b;
}
__device__ __forceinline__ void xcd_barrier_complete(unsigned* bar, unsigned x, unsigned& nloc, unsigned& nx) {
    const unsigned G = gridDim.x * gridDim.y * gridDim.z;
    unsigned sum, cnt, mine, sp = 0u;
    for (;;) {
        sum = 0u; cnt = 0u; mine = 0u;
#pragma unroll
        for (unsigned j = 0; j < 16; ++j) { const unsigned c = xb_ld(&bar[XB_XCNT(j)]); sum += c; cnt += (c > 0u) ? 1u : 0u; mine = (j == x) ? c : mine; }
        if (sum == G) break;
        __builtin_amdgcn_s_sleep(1);
        if ((++sp & 255u) == 0u) { if (xb_ld(&bar[XB_TMO])) break; if (sp > XB_SPIN_CAP) { atomicAdd(&bar[XB_TMO], 1u); break; } }
    }
    nloc = mine > 0u ? mine : 1u; nx = cnt > 0u ? cnt : 1u;
}
__device__ __forceinline__ void xcd_barrier(const XcdBarrier& b) {
    asm volatile("s_waitcnt vmcnt(0)" ::: "memory");
    __syncthreads();
    if (threadIdx.x == 0) {
        unsigned* bar = b.bar;
        __builtin_amdgcn_s_waitcnt(0);
        unsigned nloc = b.st[0], nx = b.st[1];
        if (nloc == 0u) { xcd_barrier_complete(bar, b.x, nloc, nx); b.st[0] = nloc; b.st[1] = nx; }
        const unsigned old = xb_add(&bar[XB_XSUB(b.x)], 1u);
        const unsigned gen = old / nloc;
        if (old + 1u == (gen + 1u) * nloc) {
            __builtin_amdgcn_fence(__ATOMIC_RELEASE, "agent");
            asm volatile("s_waitcnt vmcnt(0)" ::: "memory");
            const unsigned og = xb_add(&bar[XB_TOP], 1u);
            const unsigned tg = og / nx;
            if (og + 1u == (tg + 1u) * nx) xb_add(&bar[XB_TOPGEN], 1u);
            else XB_SPIN(xb_ld(&bar[XB_TOPGEN]) == tg, bar);
            __builtin_amdgcn_fence(__ATOMIC_ACQUIRE, "agent");
            xb_add(&bar[XB_XGEN(b.x)], 1u);
            asm volatile("s_waitcnt vmcnt(0)" ::: "memory");
        } else {
            XB_SPIN(xb_ld(&bar[XB_XGEN(b.x)]) == gen, bar);
            __builtin_amdgcn_fence(__ATOMIC_ACQUIRE, "agent");
            asm volatile("s_waitcnt vmcnt(0)" ::: "memory");
        }
    }
    __syncthreads();
}

struct Frame {
    LAS unsigned char* lds;
    int tid, lane, wave, vcu, G;
    const float* in[29];
    float* out;
    unsigned char* ws;
};
#define WSP(T_, off) ((T_*)(F.ws + (off)))
__device__ __forceinline__ float wave_sum(float v) {
#pragma unroll
    for (int o = 1; o < 64; o <<= 1) v += __shfl_xor(v, o);
    return v;
}
__device__ __forceinline__ float wave_max(float v) {
#pragma unroll
    for (int o = 1; o < 64; o <<= 1) v = fmaxf(v, __shfl_xor(v, o));
    return v;
}

__device__ __forceinline__ void p0_transpose_item(const float* W, int K, int N, int k0, int n0, bf16* WT, int dst_row0, LAS float* scr, int lane) {
#pragma unroll 8
    for (int i = 0; i < 32; ++i) { const int kk = 2 * i + (lane >> 5); scr[kk * 33 + (lane & 31)] = W[(size_t)(k0 + kk) * N + n0 + (lane & 31)]; }
    LDS_WAIT(); asm volatile("" ::: "memory");
    const int c = lane & 7;
#pragma unroll
    for (int j = 0; j < 4; ++j) { const int n = (lane >> 3) + 8 * j; const LAS float* s = scr + (8 * c) * 33 + n;
        v4u o; o.x = pk2(s[0 * 33], s[1 * 33]); o.y = pk2(s[2 * 33], s[3 * 33]); o.z = pk2(s[4 * 33], s[5 * 33]); o.w = pk2(s[6 * 33], s[7 * 33]);
        *(GAS v4u*)(WT + (size_t)(dst_row0 + n) * K + k0 + 8 * c) = o; }
    LDS_WAIT(); asm volatile("" ::: "memory");
}
__device__ __forceinline__ void ln_row(const float* xrow, const float* g, const float* b, float* of32, bf16* obf, int lane, float pre_scale) {
    const GAS f32x4* xr = (const GAS f32x4*)xrow + lane;
    f32x4 v[4]; float s = 0.f;
#pragma unroll
    for (int j = 0; j < 4; ++j) { v[j] = xr[64 * j] * pre_scale; s += (v[j].x + v[j].y) + (v[j].z + v[j].w); }
    const float mean = wave_sum(s) * (1.f / D); float s2 = 0.f;
#pragma unroll
    for (int j = 0; j < 4; ++j) { v[j] = v[j] - mean; s2 += (v[j].x * v[j].x + v[j].y * v[j].y) + (v[j].z * v[j].z + v[j].w * v[j].w); }
    const float rstd = 1.f / sqrtf(wave_sum(s2) * (1.f / D) + LN_EPS);
#pragma unroll
    for (int j = 0; j < 4; ++j) { const f32x4 gg = ((const GAS f32x4*)g)[lane + 64 * j], bb = ((const GAS f32x4*)b)[lane + 64 * j]; v[j] = v[j] * rstd * gg + bb; }
    if (of32) { GAS f32x4* o = (GAS f32x4*)of32 + lane;
#pragma unroll
        for (int j = 0; j < 4; ++j) o[64 * j] = v[j]; }
    if (obf) { GAS unsigned long long* o8 = (GAS unsigned long long*)obf + lane;
#pragma unroll
        for (int j = 0; j < 4; ++j) o8[64 * j] = (unsigned long long)pk2(v[j].x, v[j].y) | ((unsigned long long)pk2(v[j].z, v[j].w) << 32); }
}

__device__ __forceinline__ void p0_prologue(Frame& F) {
    LAS float* scr = (LAS float*)(F.lds + F.wave * 16384);
    const int gw = F.vcu * NWAVES + F.wave, NGW = F.G * NWAVES;
    const int gt = F.vcu * 512 + F.tid, NGT = F.G * 512;
    constexpr int I_IN = 16 * 225, I_GLA = 16 * 32, I_FN = 8 * 32, I_MEM = 8 * 32, I_KV = 16 * 32, I_OUT = 16 * 32, I_RT = 16, I_GU = 32 * 16 * 64, I_DN = 32 * 16 * 32;
    constexpr int NITEMS = I_IN + I_GLA + I_FN + I_MEM + I_KV + I_OUT + I_RT + I_GU + I_DN;
    for (int it = gw; it < NITEMS; it += NGW) {
        int r = it;
        if (r < I_IN) { const int kb = r / 225, nb = r % 225; int dst;
            if (nb < 96) dst = nb * 32; else if (nb == 96) dst = LR_OFF; else if (nb < 113) continue; else if (nb < 129) dst = nb * 32 - MQ_SRC + MQ_OFF; else dst = nb * 32 - G_SRC + G_OFF;
            p0_transpose_item(F.in[6], 1024, IN_W, 64 * kb, 32 * nb, WSP(bf16, WS_WIN), dst, scr, F.lane); continue; } r -= I_IN;
        if (r < I_GLA) { p0_transpose_item(F.in[13], 1024, 1024, 64 * (r / 32), 32 * (r % 32), WSP(bf16, WS_WGLA), 32 * (r % 32), scr, F.lane); continue; } r -= I_GLA;
        if (r < I_FN) { p0_transpose_item(F.in[14], 512, 1024, 64 * (r / 32), 32 * (r % 32), WSP(bf16, WS_WFN), 32 * (r % 32), scr, F.lane); continue; } r -= I_FN;
        if (r < I_MEM) { p0_transpose_item(F.in[15], 512, 1024, 64 * (r / 32), 32 * (r % 32), WSP(bf16, WS_WMEM), 32 * (r % 32), scr, F.lane); continue; } r -= I_MEM;
        if (r < I_KV) { p0_transpose_item(F.in[16], 1024, 1024, 64 * (r / 32), 32 * (r % 32), WSP(bf16, WS_WKV), 32 * (r % 32), scr, F.lane); continue; } r -= I_KV;
        if (r < I_OUT) { p0_transpose_item(F.in[17], 1024, 1024, 64 * (r / 32), 32 * (r % 32), WSP(bf16, WS_WOUT), 32 * (r % 32), scr, F.lane); continue; } r -= I_OUT;
        if (r < I_RT) { p0_transpose_item(F.in[21], 1024, 32, 64 * r, 0, WSP(bf16, WS_WRT), 0, scr, F.lane); continue; } r -= I_RT;
        if (r < I_GU) { const int e = r / 1024, q = r % 1024, kb = q / 64, nb = q % 64, j = nb * 32;
            const int dst = (j < 1024) ? (j / 128) * 256 + (j % 128) : ((j - 1024) / 128) * 256 + 128 + ((j - 1024) % 128);
            p0_transpose_item(F.in[23] + (size_t)e * 1024 * 2048, 1024, 2048, 64 * kb, j, WSP(bf16, WS_WGU) + (size_t)e * 2048 * 1024, dst, scr, F.lane); continue; } r -= I_GU;
        { const int e = r / 512, q = r % 512, kb = q / 32, nb = q % 32;
            p0_transpose_item(F.in[25] + (size_t)e * 1024 * 1024, 1024, 1024, 64 * kb, 32 * nb, WSP(bf16, WS_WDN) + (size_t)e * 1024 * 1024, 32 * nb, scr, F.lane); }
    }
    { bf16* w = WSP(bf16, WS_WIN) + (size_t)(LR_OFF + 32) * 1024; for (int i = gt; i < (NP - LR_OFF - 32) * 1024 / 8; i += NGT) ((GAS v4u*)w)[i] = (v4u){0u, 0u, 0u, 0u}; }
    { float* bp = WSP(float, WS_BIN); const float* b = F.in[7];
      for (int i = gt; i < NP; i += NGT) { float v = 0.f;
          if (i < 3072) v = b[i]; else if (i < G_OFF) v = b[i - MQ_OFF + MQ_SRC]; else if (i < LR_OFF) v = b[i - G_OFF + G_SRC]; else if (i < LR_OFF + 32) v = b[i - LR_OFF + LR_SRC];
          bp[i] = v; } }
    { float* bp = WSP(float, WS_BGU); const float* b = F.in[24];
      for (int i = gt; i < NE * 2048; i += NGT) { const int e = i / 2048, d = i % 2048, pn = d / 256, w = d % 256; const int src = (w < 128) ? pn * 128 + w : 1024 + pn * 128 + (w - 128); bp[i] = b[e * 2048 + src]; } }
    __syncthreads();
    { LAS float* t128 = (LAS float*)F.lds;
      if (F.tid < 128) { float sn, cs; sincospif((float)F.tid * (1.0f / 64.0f), &sn, &cs); t128[2 * F.tid] = cs; t128[2 * F.tid + 1] = sn; }
      __syncthreads();
      bf16* wz = WSP(bf16, WS_WZ); const float* w = F.in[6]; const float rs = 0.08838834764831845f;
      for (int idx = gt; idx < 1024 * 512; idx += NGT) { const int k = idx & 1023, gc = idx >> 10, g = gc >> 7, cp = gc & 127;
          const float* src = w + (size_t)k * IN_W + FN_SRC + g * 128; float ar = 0.f, ai = 0.f;
          for (int c4 = 0; c4 < 32; ++c4) { const f32x4 x = *(const GAS f32x4*)(src + 4 * c4);
#pragma unroll
              for (int j = 0; j < 4; ++j) { const int mm = ((4 * c4 + j) * cp) & 127; const float cs = t128[2 * mm], sn = t128[2 * mm + 1]; ar += x[j] * cs; ai -= x[j] * sn; } }
          wz[(size_t)(gc * 2 + 0) * 1024 + k] = (bf16)f2bf(ar * rs); wz[(size_t)(gc * 2 + 1) * 1024 + k] = (bf16)f2bf(ai * rs); }
      float* bz = WSP(float, WS_BZ); const float* b = F.in[7];
      for (int gc = gt; gc < 512; gc += NGT) { const int g = gc >> 7, cp = gc & 127; float ar = 0.f, ai = 0.f;
          for (int c = 0; c < 128; ++c) { const int mm = (c * cp) & 127; const float cs = t128[2 * mm], sn = t128[2 * mm + 1]; const float x = b[FN_SRC + g * 128 + c]; ar += x * cs; ai -= x * sn; }
          bz[gc * 2] = ar * rs; bz[gc * 2 + 1] = ai * rs; } }
    __syncthreads();
    { LAS unsigned* tab = (LAS unsigned*)F.lds;
      for (int m = F.tid; m < 4096; m += 512) { float sn, cs; sincospif((float)m * (1.0f / 2048.0f), &sn, &cs); tab[m] = pk2(cs, sn); }
      __syncthreads();
      bf16* dft = WSP(bf16, WS_DFT);
      for (int idx = gt; idx < 4096 * 512; idx += NGT) { const int sp = idx >> 9, s0 = (idx & 511) * 8; unsigned cw[4], sw[4];
#pragma unroll
          for (int j = 0; j < 4; ++j) { const unsigned a = tab[((s0 + 2 * j) * sp) & 4095], b = tab[((s0 + 2 * j + 1) * sp) & 4095]; cw[j] = (a & 0xffffu) | (b << 16); sw[j] = (a >> 16) | (b & 0xffff0000u); }
          *(GAS v4u*)(dft + (size_t)sp * 8192 + s0) = (v4u){cw[0], cw[1], cw[2], cw[3]}; *(GAS v4u*)(dft + (size_t)sp * 8192 + 4096 + s0) = (v4u){sw[0], sw[1], sw[2], sw[3]}; }
      __syncthreads(); }
    for (int m = gw; m < T; m += NGW) ln_row(F.in[0] + (size_t)m * D, F.in[2], F.in[3], WSP(float, WS_H) + (size_t)m * D, WSP(bf16, WS_HB) + (size_t)m * D, F.lane, 1.0f);
    for (int m = gw; m < NB * MEM; m += NGW) ln_row(F.in[1] + (size_t)m * D, F.in[4], F.in[5], nullptr, WSP(bf16, WS_MEMN) + (size_t)m * D, F.lane, 1.0f);
}

using pg8::Unit; using pg8::cvt_pk_bf16;
struct EpiBias {
    static constexpr bool PERM = true;
    bf16* O; int ldc; const float* bias;
    __device__ __forceinline__ void operator()(const f32x4 (&acc)[2][2][4][2], const Unit& u, int wr, int wc, int fr, int fq) const {
        const int row0 = u.pm * 256 + wr * 64 + fr, col0 = u.pn * 256 + wc * 32 + 8 * fq;
        f32x4 bv[2][2];
#pragma unroll
        for (int bj = 0; bj < 2; ++bj)
#pragma unroll
            for (int n = 0; n < 2; ++n) bv[bj][n] = bias ? *(const f32x4*)(bias + col0 + bj * 128 + 4 * n) : (f32x4){0.f, 0.f, 0.f, 0.f};
#pragma unroll
        for (int ai = 0; ai < 2; ++ai)
#pragma unroll
            for (int m = 0; m < 4; ++m) { bf16* rowp = O + (size_t)(row0 + ai * 128 + m * 16) * ldc + col0;
#pragma unroll
                for (int bj = 0; bj < 2; ++bj) { const f32x4 v0 = acc[ai][bj][m][0] + bv[bj][0], v1 = acc[ai][bj][m][1] + bv[bj][1];
                    v4u w; w.x = cvt_pk_bf16(v0[0], v0[1]); w.y = cvt_pk_bf16(v0[2], v0[3]); w.z = cvt_pk_bf16(v1[0], v1[1]); w.w = cvt_pk_bf16(v1[2], v1[3]);
                    *(v4u*)(rowp + bj * 128) = w; } }
    }
};
struct EpiZT {
    static constexpr bool PERM = true;
    bf16* O; const float* bias;
    __device__ __forceinline__ void operator()(const f32x4 (&acc)[2][2][4][2], const Unit& u, int wr, int wc, int fr, int fq) const {
        const int row0 = u.pm * 256 + wr * 64 + fr, tok0 = u.pn * 256 + wc * 32 + 8 * fq, b = tok0 >> 12, s0 = tok0 & 4095;
#pragma unroll
        for (int ai = 0; ai < 2; ++ai)
#pragma unroll
            for (int m = 0; m < 4; ++m) { const int row = row0 + ai * 128 + m * 16; const float bz = bias[row]; bf16* rowp = O + ((size_t)b * 1024 + row) * 4096 + s0;
#pragma unroll
                for (int bj = 0; bj < 2; ++bj) { const f32x4 v0 = acc[ai][bj][m][0] + bz, v1 = acc[ai][bj][m][1] + bz;
                    v4u w; w.x = cvt_pk_bf16(v0[0], v0[1]); w.y = cvt_pk_bf16(v0[2], v0[3]); w.z = cvt_pk_bf16(v1[0], v1[1]); w.w = cvt_pk_bf16(v1[2], v1[3]);
                    *(v4u*)(rowp + bj * 128) = w; } }
    }
};
struct EpiFnet {
    static constexpr bool PERM = true;
    bf16* O;
    __device__ __forceinline__ void operator()(const f32x4 (&acc)[2][2][4][2], const Unit& u, int wr, int wc, int fr, int fq) const {
        const int row0 = u.z * 4096 + u.pm * 256 + wr * 64 + fr, col0 = u.pn * 256 + wc * 32 + 8 * fq;
#pragma unroll
        for (int ai = 0; ai < 2; ++ai)
#pragma unroll
            for (int m = 0; m < 4; ++m) { bf16* rowp = O + (size_t)(row0 + ai * 128 + m * 16) * 512 + col0;
#pragma unroll
                for (int bj = 0; bj < 2; ++bj) { const f32x4 v0 = acc[ai][bj][m][0] * 0.015625f, v1 = acc[ai][bj][m][1] * 0.015625f;
                    v4u w; w.x = cvt_pk_bf16(v0[0], v0[1]); w.y = cvt_pk_bf16(v0[2], v0[3]); w.z = cvt_pk_bf16(v1[0], v1[1]); w.w = cvt_pk_bf16(v1[2], v1[3]);
                    *(v4u*)(rowp + bj * 128) = w; } }
    }
};
template <int MODE> struct EpiGate {
    static constexpr bool PERM = true;
    float* MG; bf16* MGB; const bf16* gate;
    __device__ __forceinline__ void operator()(const f32x4 (&acc)[2][2][4][2], const Unit& u, int wr, int wc, int fr, int fq) const {
        const int row0 = u.pm * 256 + wr * 64 + fr, col0 = u.pn * 256 + wc * 32 + 8 * fq;
#pragma unroll
        for (int ai = 0; ai < 2; ++ai)
#pragma unroll
            for (int m = 0; m < 4; ++m) { const size_t row = (size_t)(row0 + ai * 128 + m * 16);
#pragma unroll
                for (int bj = 0; bj < 2; ++bj) { const int col = col0 + bj * 128;
                    const v4u gw = *(const v4u*)(gate + row * NP + col);
                    float gs[8] = {bflo(gw.x), bfhi(gw.x), bflo(gw.y), bfhi(gw.y), bflo(gw.z), bfhi(gw.z), bflo(gw.w), bfhi(gw.w)};
#pragma unroll
                    for (int j = 0; j < 8; ++j) gs[j] = 1.0f / (1.0f + __expf(-gs[j]));
                    f32x4 v0 = acc[ai][bj][m][0] * (f32x4){gs[0], gs[1], gs[2], gs[3]}, v1 = acc[ai][bj][m][1] * (f32x4){gs[4], gs[5], gs[6], gs[7]};
                    float* mp = MG + row * 1024 + col;
                    if (MODE >= 1) { v0 += *(const f32x4*)mp; v1 += *(const f32x4*)(mp + 4); }
                    if (MODE <= 1) { *(f32x4*)mp = v0; *(f32x4*)(mp + 4) = v1; }
                    else { v4u w; w.x = cvt_pk_bf16(v0[0], v0[1]); w.y = cvt_pk_bf16(v0[2], v0[3]); w.z = cvt_pk_bf16(v1[0], v1[1]); w.w = cvt_pk_bf16(v1[2], v1[3]); *(v4u*)(MGB + row * 1024 + col) = w; } } }
    }
};
struct EpiOut {
    static constexpr bool PERM = false;
    float* H; const float* bias;
    __device__ __forceinline__ void operator()(const f32x4 (&acc)[2][2][4][2], const Unit& u, int wr, int wc, int fr, int fq) const {
        const int row0 = u.pm * 256 + wr * 64 + fr, col0 = u.pn * 256 + wc * 32 + 4 * fq;
        f32x4 bv[2][2];
#pragma unroll
        for (int bj = 0; bj < 2; ++bj)
#pragma unroll
            for (int n = 0; n < 2; ++n) bv[bj][n] = *(const f32x4*)(bias + col0 + bj * 128 + n * 16);
#pragma unroll
        for (int ai = 0; ai < 2; ++ai)
#pragma unroll
            for (int m = 0; m < 4; ++m) { float* rowp = H + (size_t)(row0 + ai * 128 + m * 16) * 1024 + col0;
#pragma unroll
                for (int bj = 0; bj < 2; ++bj)
#pragma unroll
                    for (int n = 0; n < 2; ++n) { float* p = rowp + bj * 128 + n * 16; const f32x4 hv = *(const f32x4*)p; *(f32x4*)p = hv * DN_ALPHA + acc[ai][bj][m][n] + bv[bj][n]; } }
    }
};

template <int NPN, bool GATHER_> struct MoeSched {
    static constexpr bool GATHER = GATHER_;
    volatile LAS int* tb;
    const int* list;
    int G, c; int lda, ldb; size_t bstride;
    __device__ __forceinline__ bool next(int i, Unit& u) const {
        const int L = i * G + c, total = tb[64] * NPN; if (L >= total) return false;
        const int tl = L / NPN; int e = 0;
        for (int j = 1; j < 32; ++j) e += (tb[32 + j] <= tl) ? 1 : 0;
        const int te = tb[32 + e + 1] - tb[32 + e], idx = L - tb[32 + e] * NPN;
        u.z = e; u.pm = idx % te; u.pn = idx / te; return true;
    }
    __device__ __forceinline__ size_t a_off(const Unit& u) const { return (size_t)(tb[32 + u.z] + u.pm) * 256 * lda * 2; }
    __device__ __forceinline__ size_t b_off(const Unit& u) const { return (size_t)u.z * bstride + (size_t)u.pn * 256 * ldb * 2; }
    __device__ __forceinline__ unsigned gather_row(const Unit& u, int r) const {
        const int rr = u.pm * 256 + r; int tok = 0; if (rr < tb[u.z]) tok = list[u.z * T + rr] >> 2;
        return (unsigned)tok * (unsigned)(lda * 2);
    }
    __device__ __forceinline__ int row_base(const Unit& u) const { return (tb[32 + u.z] + u.pm) * 256; }
    __device__ __forceinline__ int nvalid(const Unit& u) const { return tb[u.z] - u.pm * 256; }
};
struct EpiSwiglu {
    static constexpr bool PERM = true;
    bf16* ACT; const float* bgu; MoeSched<8, true> S;
    __device__ __forceinline__ void operator()(const f32x4 (&acc)[2][2][4][2], const Unit& u, int wr, int wc, int fr, int fq) const {
        const int rbase = S.row_base(u) + wr * 64 + fr, cw = wc * 32 + 8 * fq;
        const float* bp = bgu + u.z * 2048 + u.pn * 256 + cw;
        const f32x4 bg0 = *(const f32x4*)bp, bg1 = *(const f32x4*)(bp + 4), bu0 = *(const f32x4*)(bp + 128), bu1 = *(const f32x4*)(bp + 132);
#pragma unroll
        for (int ai = 0; ai < 2; ++ai)
#pragma unroll
            for (int m = 0; m < 4; ++m) { const size_t row = (size_t)(rbase + ai * 128 + m * 16);
                float o[8];
#pragma unroll
                for (int n = 0; n < 2; ++n) { const f32x4 gt = acc[ai][0][m][n] + (n ? bg1 : bg0), up = acc[ai][1][m][n] + (n ? bu1 : bu0);
#pragma unroll
                    for (int j = 0; j < 4; ++j) { const float gg = fminf(gt[j], 7.0f), uu = fminf(fmaxf(up[j], -7.0f), 7.0f); o[4 * n + j] = (uu + 1.0f) * gg / (1.0f + __expf(-1.702f * gg)); } }
                v4u w; w.x = cvt_pk_bf16(o[0], o[1]); w.y = cvt_pk_bf16(o[2], o[3]); w.z = cvt_pk_bf16(o[4], o[5]); w.w = cvt_pk_bf16(o[6], o[7]);
                *(v4u*)(ACT + row * 1024 + u.pn * 128 + cw) = w; }
    }
};
struct EpiDown {
    static constexpr bool PERM = true;
    bf16* YB; const float* bd; const float* topw; const int* list; MoeSched<4, false> S;
    __device__ __forceinline__ void operator()(const f32x4 (&acc)[2][2][4][2], const Unit& u, int wr, int wc, int fr, int fq) const {
        const int nv = S.nvalid(u), col0 = u.pn * 256 + wc * 32 + 8 * fq;
        const float* bp = bd + u.z * 1024 + col0;
        f32x4 bv[2][2];
#pragma unroll
        for (int bj = 0; bj < 2; ++bj)
#pragma unroll
            for (int n = 0; n < 2; ++n) bv[bj][n] = *(const f32x4*)(bp + bj * 128 + 4 * n);
#pragma unroll
        for (int ai = 0; ai < 2; ++ai)
#pragma unroll
            for (int m = 0; m < 4; ++m) { const int r = ai * 128 + wr * 64 + m * 16 + fr;
                if (r < nv) { const int a = list[u.z * T + u.pm * 256 + r]; const float w = topw[a]; bf16* rowp = YB + (size_t)a * 1024 + col0;
#pragma unroll
                    for (int bj = 0; bj < 2; ++bj) { const f32x4 v0 = (acc[ai][bj][m][0] + bv[bj][0]) * w, v1 = (acc[ai][bj][m][1] + bv[bj][1]) * w;
                        v4u o; o.x = cvt_pk_bf16(v0[0], v0[1]); o.y = cvt_pk_bf16(v0[2], v0[3]); o.z = cvt_pk_bf16(v1[0], v1[1]); o.w = cvt_pk_bf16(v1[2], v1[3]);
                        *(v4u*)(rowp + bj * 128) = o; } } }
    }
};

__device__ __forceinline__ void gla_naive(Frame& F, int bhd) {
    const int dir = bhd & 1, h = (bhd >> 1) & 3, b = bhd >> 3;
    const bf16* proj = WSP(bf16, WS_PROJ);
    float* O = dir ? WSP(float, WS_OB) : WSP(float, WS_OF);
    const float* Wd = dir ? F.in[10] : F.in[8]; const float* bd = dir ? F.in[11] : F.in[9];
    LAS float* la = (LAS float*)F.lds;
    LAS float* lk = la + 16 * 128;
    LAS float* lq = lk + 16 * 128;
    LAS float* lp = lq + 16 * 128;
    const int dvc = F.tid & 255, kh = F.tid >> 8;
    float S[64];
#pragma unroll
    for (int j = 0; j < 64; ++j) S[j] = 0.f;
    for (int blk = 0; blk < SEQ / 16; ++blk) {
        __syncthreads();
        for (int i = F.tid; i < 16 * 128; i += 512) { const int tt = i >> 7, j = i & 127; const int s = dir ? (SEQ - 1 - (blk * 16 + tt)) : (blk * 16 + tt); const size_t t = (size_t)b * SEQ + s;
            const bf16* pr = proj + t * NP; float z = bd[h * 128 + j];
#pragma unroll
            for (int r = 0; r < 16; ++r) z += bf2f(pr[LR_OFF + dir * 16 + r]) * Wd[r * 512 + h * 128 + j];
            const float ls = fminf(z, 0.f) - log1pf(__expf(-fabsf(z)));
            la[i] = __expf(ls * (1.0f / 16.0f)); lk[i] = bf2f(pr[K_OFF + h * 128 + j]); lq[i] = bf2f(pr[Q_OFF + h * 128 + j]) * 0.08838834764831845f; }
        __syncthreads();
        for (int tt = 0; tt < 16; ++tt) { const int s = dir ? (SEQ - 1 - (blk * 16 + tt)) : (blk * 16 + tt); const size_t t = (size_t)b * SEQ + s;
            const float v = bf2f(proj[t * NP + V_OFF + h * 256 + dvc]); float o = 0.f;
            const LAS f32x4* a4 = (const LAS f32x4*)(la + tt * 128 + kh * 64); const LAS f32x4* k4 = (const LAS f32x4*)(lk + tt * 128 + kh * 64); const LAS f32x4* q4 = (const LAS f32x4*)(lq + tt * 128 + kh * 64);
#pragma unroll
            for (int j4 = 0; j4 < 16; ++j4) { const f32x4 av = a4[j4], kv = k4[j4], qv = q4[j4];
#pragma unroll
                for (int j = 0; j < 4; ++j) { S[4 * j4 + j] = av[j] * S[4 * j4 + j] + kv[j] * v; o += qv[j] * S[4 * j4 + j]; } }
            lp[(tt * 2 + kh) * 256 + dvc] = o; }
        __syncthreads();
        for (int i = F.tid; i < 16 * 256; i += 512) { const int tt = i >> 8, c = i & 255; const int s = dir ? (SEQ - 1 - (blk * 16 + tt)) : (blk * 16 + tt); const size_t t = (size_t)b * SEQ + s;
            O[t * 1024 + h * 256 + c] = lp[(tt * 2) * 256 + c] + lp[(tt * 2 + 1) * 256 + c]; }
    }
    __syncthreads();
}

__device__ __forceinline__ void gla_finalize(Frame& F) {
    const int gw = F.vcu * NWAVES + F.wave, NGW = F.G * NWAVES;
    const float* of = WSP(float, WS_OF); const float* ob = WSP(float, WS_OB); const bf16* proj = WSP(bf16, WS_PROJ); bf16* og = WSP(bf16, WS_OG);
    const f32x4 gg = ((const GAS f32x4*)F.in[12])[F.lane];
    for (int t = gw; t < T; t += NGW) {
#pragma unroll
        for (int j = 0; j < 4; ++j) { f32x4 v = ((const GAS f32x4*)(of + (size_t)t * 1024))[F.lane + 64 * j] + ((const GAS f32x4*)(ob + (size_t)t * 1024))[F.lane + 64 * j];
            const float ms = wave_sum((v.x * v.x + v.y * v.y) + (v.z * v.z + v.w * v.w)) * (1.0f / 256.0f); const float rs = 1.0f / sqrtf(ms + RMS_EPS);
            const v2u rw = *(const GAS v2u*)(proj + (size_t)t * NP + R_OFF + 256 * j + 4 * F.lane);
            const float r0 = bflo(rw.x), r1 = bfhi(rw.x), r2 = bflo(rw.y), r3 = bfhi(rw.y);
            v = v * rs * gg;
            v.x *= r0 / (1.0f + __expf(-r0)); v.y *= r1 / (1.0f + __expf(-r1)); v.z *= r2 / (1.0f + __expf(-r2)); v.w *= r3 / (1.0f + __expf(-r3));
            *(GAS v2u*)(og + (size_t)t * 1024 + 256 * j + 4 * F.lane) = (v2u){pk2(v.x, v.y), pk2(v.z, v.w)}; }
    }
}

__device__ __forceinline__ void xattn_naive(Frame& F) {
    const int gw = F.vcu * NWAVES + F.wave, NGW = F.G * NWAVES;
    const bf16* proj = WSP(bf16, WS_PROJ); const bf16* kv = WSP(bf16, WS_KV); bf16* om = WSP(bf16, WS_OM);
    LAS float* qs = (LAS float*)(F.lds + F.wave * 8192);
    LAS float* ps = qs + 512;
    for (int task = gw; task < T; task += NGW) {
        const int h = task & 3, t0 = (task >> 2) * 4, b = t0 >> 12;
        { const int tk = F.lane >> 4, d0 = (F.lane & 15) * 8; const v4u w = *(const GAS v4u*)(proj + (size_t)(t0 + tk) * NP + MQ_OFF + h * 128 + d0);
          LAS float* q = qs + tk * 128 + d0; q[0] = bflo(w.x); q[1] = bfhi(w.x); q[2] = bflo(w.y); q[3] = bfhi(w.y); q[4] = bflo(w.z); q[5] = bfhi(w.z); q[6] = bflo(w.w); q[7] = bfhi(w.w); }
        LDS_WAIT(); asm volatile("" ::: "memory");
        float sc[4][4];
#pragma unroll
        for (int i = 0; i < 4; ++i)
#pragma unroll
            for (int tk = 0; tk < 4; ++tk) sc[tk][i] = 0.f;
#pragma unroll
        for (int i = 0; i < 4; ++i) { const bf16* kr = kv + (size_t)(b * 256 + F.lane + 64 * i) * 1024 + h * 128;
#pragma unroll 2
            for (int c = 0; c < 16; ++c) { const v4u w = *(const GAS v4u*)(kr + 8 * c); const float kf[8] = {bflo(w.x), bfhi(w.x), bflo(w.y), bfhi(w.y), bflo(w.z), bfhi(w.z), bflo(w.w), bfhi(w.w)};
#pragma unroll
                for (int tk = 0; tk < 4; ++tk) { const f32x4 qa = *(const LAS f32x4*)(qs + tk * 128 + 8 * c), qb = *(const LAS f32x4*)(qs + tk * 128 + 8 * c + 4);
                    sc[tk][i] += (qa[0] * kf[0] + qa[1] * kf[1]) + (qa[2] * kf[2] + qa[3] * kf[3]) + (qb[0] * kf[4] + qb[1] * kf[5]) + (qb[2] * kf[6] + qb[3] * kf[7]); } } }
#pragma unroll
        for (int tk = 0; tk < 4; ++tk) { float mx = -3.0e38f;
#pragma unroll
            for (int i = 0; i < 4; ++i) { sc[tk][i] *= 0.08838834764831845f; mx = fmaxf(mx, sc[tk][i]); }
            mx = wave_max(mx); float sm = 0.f;
#pragma unroll
            for (int i = 0; i < 4; ++i) { sc[tk][i] = __expf(sc[tk][i] - mx); sm += sc[tk][i]; }
            sm = 1.0f / wave_sum(sm);
#pragma unroll
            for (int i = 0; i < 4; ++i) ps[tk * 256 + F.lane + 64 * i] = sc[tk][i] * sm; }
        LDS_WAIT(); asm volatile("" ::: "memory");
        float o[4][2];
#pragma unroll
        for (int tk = 0; tk < 4; ++tk) { o[tk][0] = 0.f; o[tk][1] = 0.f; }
        const bf16* vr = kv + (size_t)(b * 256) * 1024 + 512 + h * 128 + 2 * F.lane;
#pragma unroll 2
        for (int k4 = 0; k4 < 64; ++k4) { float v0[4], v1[4];
#pragma unroll
            for (int j = 0; j < 4; ++j) { const unsigned w = *(const GAS unsigned*)(vr + (size_t)(4 * k4 + j) * 1024); v0[j] = bflo(w); v1[j] = bfhi(w); }
#pragma unroll
            for (int tk = 0; tk < 4; ++tk) { const f32x4 p = *(const LAS f32x4*)(ps + tk * 256 + 4 * k4);
#pragma unroll
                for (int j = 0; j < 4; ++j) { o[tk][0] += p[j] * v0[j]; o[tk][1] += p[j] * v1[j]; } } }
#pragma unroll
        for (int tk = 0; tk < 4; ++tk) *(GAS unsigned*)(om + (size_t)(t0 + tk) * 512 + h * 128 + 2 * F.lane) = pk2(o[tk][0], o[tk][1]);
        LDS_WAIT(); asm volatile("" ::: "memory");
    }
}

__device__ __forceinline__ void router_phase(Frame& F) {
    LAS int* hist = (LAS int*)(F.lds);
    const bf16* h1b = WSP(bf16, WS_HB); const bf16* wrt = WSP(bf16, WS_WRT); const float* brt = F.in[22];
    int* list = WSP(int, WS_RT); float* topw = WSP(float, WS_TOPW); unsigned* cnt = (unsigned*)(F.ws + WS_CTL) + CW_CNT;
    const int tq = F.lane & 15, q = F.lane >> 4;
    for (int it = F.vcu; it < T / 128; it += F.G) {
        if (F.tid < 64) hist[F.tid] = 0;
        __syncthreads();
        const int tok = it * 128 + F.wave * 16 + tq;
        f32x4 a0 = {0.f, 0.f, 0.f, 0.f}, a1 = {0.f, 0.f, 0.f, 0.f};
        const bf16* ap0 = wrt + (size_t)tq * 1024 + 8 * q; const bf16* ap1 = wrt + (size_t)(16 + tq) * 1024 + 8 * q; const bf16* bp = h1b + (size_t)tok * 1024 + 8 * q;
#pragma unroll 4
        for (int ks = 0; ks < 32; ++ks) { const bf16x8 bf = *(const GAS bf16x8*)(bp + 32 * ks);
            a0 = __builtin_amdgcn_mfma_f32_16x16x32_bf16(*(const GAS bf16x8*)(ap0 + 32 * ks), bf, a0, 0, 0, 0);
            a1 = __builtin_amdgcn_mfma_f32_16x16x32_bf16(*(const GAS bf16x8*)(ap1 + 32 * ks), bf, a1, 0, 0, 0); }
        float lv[8]; int taken = 0;
#pragma unroll
        for (int r = 0; r < 4; ++r) { lv[r] = a0[r] + brt[4 * q + r]; lv[4 + r] = a1[r] + brt[16 + 4 * q + r]; }
        float tv[4]; int te[4];
#pragma unroll
        for (int k = 0; k < 4; ++k) { float bv = -3.0e38f; int be = 64;
#pragma unroll
            for (int r = 0; r < 8; ++r) { const int e = (r < 4) ? 4 * q + r : 16 + 4 * q + (r - 4); const bool ok = !((taken >> r) & 1) && (lv[r] > bv || (lv[r] == bv && e < be)); bv = ok ? lv[r] : bv; be = ok ? e : be; }
#pragma unroll
            for (int o = 16; o < 64; o <<= 1) { const float ov = __shfl_xor(bv, o); const int oe = __shfl_xor(be, o); const bool tk = (ov > bv) || (ov == bv && oe < be); bv = tk ? ov : bv; be = tk ? oe : be; }
            tv[k] = bv; te[k] = be;
#pragma unroll
            for (int r = 0; r < 8; ++r) { const int e = (r < 4) ? 4 * q + r : 16 + 4 * q + (r - 4); if (e == be) taken |= (1 << r); } }
        const float e1 = __expf(tv[1] - tv[0]), e2 = __expf(tv[2] - tv[0]), e3 = __expf(tv[3] - tv[0]); const float inv = 1.0f / (1.0f + e1 + e2 + e3);
        const float wk = (q == 0 ? 1.0f : q == 1 ? e1 : q == 2 ? e2 : e3) * inv; const int ek = (q == 0 ? te[0] : q == 1 ? te[1] : q == 2 ? te[2] : te[3]);
        const int a = tok * 4 + q;
        const int lpos = __hip_atomic_fetch_add(&hist[ek], 1, __ATOMIC_RELAXED, __HIP_MEMORY_SCOPE_WORKGROUP);
        __syncthreads();
        if (F.tid < 32) hist[32 + F.tid] = (int)__hip_atomic_fetch_add(cnt + F.tid, (unsigned)hist[F.tid], RLX_AGENT);
        __syncthreads();
        list[ek * T + hist[32 + ek] + lpos] = a; topw[a] = wk;
        __syncthreads();
    }
}

__device__ __forceinline__ void final_phase(Frame& F) {
    const int gw = F.vcu * NWAVES + F.wave, NGW = F.G * NWAVES;
    const float* h1 = WSP(float, WS_H); const bf16* yb = WSP(bf16, WS_YB);
    for (int t = gw; t < T; t += NGW) {
        f32x4 v[4]; float s = 0.f;
#pragma unroll
        for (int j = 0; j < 4; ++j) { v[j] = ((const GAS f32x4*)(h1 + (size_t)t * 1024))[F.lane + 64 * j] * DN_ALPHA;
#pragma unroll
            for (int k = 0; k < 4; ++k) { const v2u w = *(const GAS v2u*)(yb + ((size_t)t * 4 + k) * 1024 + 256 * j + 4 * F.lane); v[j] += (f32x4){bflo(w.x), bfhi(w.x), bflo(w.y), bfhi(w.y)}; }
            s += (v[j].x + v[j].y) + (v[j].z + v[j].w); }
        const float mean = wave_sum(s) * (1.f / D); float s2 = 0.f;
#pragma unroll
        for (int j = 0; j < 4; ++j) { v[j] = v[j] - mean; s2 += (v[j].x * v[j].x + v[j].y * v[j].y) + (v[j].z * v[j].z + v[j].w * v[j].w); }
        const float rstd = 1.f / sqrtf(wave_sum(s2) * (1.f / D) + LN_EPS);
#pragma unroll
        for (int j = 0; j < 4; ++j) { const f32x4 gg = ((const GAS f32x4*)F.in[27])[F.lane + 64 * j], bb = ((const GAS f32x4*)F.in[28])[F.lane + 64 * j];
            ((GAS f32x4*)(F.out + (size_t)t * 1024))[F.lane + 64 * j] = v[j] * rstd * gg + bb; }
    }
}

struct Args { const float* in[29]; float* out; unsigned char* ws; int ph_lo, ph_hi, li, pad; };
__global__ void __launch_bounds__(NWAVES * 64, 2) mega_fwd(Args args) {
    extern __shared__ __attribute__((aligned(16))) unsigned char lds[];
    Frame F;
    F.lds = (LAS unsigned char*)lds;
    F.tid = threadIdx.x; F.lane = F.tid & 63; F.wave = __builtin_amdgcn_readfirstlane(F.tid >> 6);
    F.G = gridDim.x; { const int bx = blockIdx.x; F.vcu = (F.G % 8 == 0) ? (bx % 8) * (F.G / 8) + bx / 8 : bx; }
#pragma unroll
    for (int i = 0; i < 29; ++i) F.in[i] = args.in[i];
    F.out = args.out; F.ws = args.ws;
    volatile LAS unsigned* MISC = (volatile LAS unsigned*)(F.lds + MISC_OFF);
    for (int u = F.tid; u < (LDS_BYTES - LDSCTL_OFF) / 4; u += NWAVES * 64) ((LAS unsigned*)(F.lds + LDSCTL_OFF))[u] = 0u;
    __syncthreads();
    unsigned* ctl = (unsigned*)(F.ws + WS_CTL);
    XcdBarrier bar; bar.bar = ctl + CW_BAR; bar.x = 0; bar.st = nullptr;
#if !MK_PER_PHASE
    bar = xcd_barrier_post(ctl + CW_BAR, MISC + 8);
#define GRID_BAR() xcd_barrier(bar)
#else
#define GRID_BAR() do {} while (0)
#endif
    const int lo = args.ph_lo, hi = args.ph_hi;
#ifndef PH_MASK
#define PH_MASK 0x7ff
#endif
#define IN(k) (((PH_MASK >> (k)) & 1) && lo <= (k) && (k) < hi)
#define BOTH(k) (IN(k) && IN((k) + 1))
    const int bx = (int)blockIdx.x;

    if (IN(0)) { p0_prologue(F); if (BOTH(0)) GRID_BAR(); }

    if (IN(1)) {
        { pg8::Gemm g{WSP(bf16, WS_HB), WSP(bf16, WS_WIN), D, D, D}; pg8::StaticOrder S; S.init(T, NP, F.G, bx, D, D);
          EpiBias E{WSP(bf16, WS_PROJ), NP, WSP(float, WS_BIN)}; pg8::gemm_phase(F.lds, g, S, E); }
        { pg8::Gemm g{WSP(bf16, WS_WZ), WSP(bf16, WS_HB), D, D, D}; pg8::StaticOrder S; S.init(1024, T, F.G, bx, D, D);
          EpiZT E{WSP(bf16, WS_ZT), WSP(float, WS_BZ)}; pg8::gemm_phase(F.lds, g, S, E); }
        { pg8::Gemm g{WSP(bf16, WS_MEMN), WSP(bf16, WS_WKV), D, D, D}; pg8::StaticOrder S; S.init(NB * MEM, 1024, F.G, F.G - 1 - bx, D, D);
          EpiBias E{WSP(bf16, WS_KV), 1024, nullptr}; pg8::gemm_phase(F.lds, g, S, E); }
        if (BOTH(1)) GRID_BAR();
    }

    if (IN(2)) {
#ifndef NO_GLA
        if (bx < 32) gla_naive(F, bx);
#endif
        { pg8::Gemm g{WSP(bf16, WS_DFT), WSP(bf16, WS_ZT), 8192, 8192, 8192}; pg8::StaticOrder S; S.init(SEQ, 512, F.G, F.G - 1 - bx, 8192, 8192, NB, 0, (size_t)512 * 8192 * 2);
          EpiFnet E{WSP(bf16, WS_F)}; pg8::gemm_phase(F.lds, g, S, E); }
        __syncthreads();
#ifndef NO_XATTN
        xattn_naive(F);
#endif
        if (BOTH(2)) GRID_BAR();
    }

    if (IN(3)) { gla_finalize(F); if (BOTH(3)) GRID_BAR(); }

    if (IN(4)) {
        const bf16* gate = WSP(bf16, WS_PROJ) + G_OFF;
        { pg8::Gemm g{WSP(bf16, WS_OG), WSP(bf16, WS_WGLA), 1024, 1024, 1024}; pg8::StaticOrder S; S.init(T, D, F.G, bx, 1024, 1024);
          EpiGate<0> E{WSP(float, WS_MG), WSP(bf16, WS_MGB), gate}; pg8::gemm_phase(F.lds, g, S, E); }
        { pg8::Gemm g{WSP(bf16, WS_F), WSP(bf16, WS_WFN), 512, 512, 512}; pg8::StaticOrder S; S.init(T, D, F.G, bx, 512, 512);
          EpiGate<1> E{WSP(float, WS_MG), WSP(bf16, WS_MGB), gate + 1024}; pg8::gemm_phase(F.lds, g, S, E); }
        { pg8::Gemm g{WSP(bf16, WS_OM), WSP(bf16, WS_WMEM), 512, 512, 512}; pg8::StaticOrder S; S.init(T, D, F.G, bx, 512, 512);
          EpiGate<2> E{WSP(float, WS_MG), WSP(bf16, WS_MGB), gate + 2048}; pg8::gemm_phase(F.lds, g, S, E); }
        if (BOTH(4)) GRID_BAR();
    }

    if (IN(5)) {
        pg8::Gemm g{WSP(bf16, WS_MGB), WSP(bf16, WS_WOUT), 1024, 1024, 1024}; pg8::StaticOrder S; S.init(T, D, F.G, bx, 1024, 1024);
        EpiOut E{WSP(float, WS_H), F.in[18]}; pg8::gemm_phase(F.lds, g, S, E);
        if (BOTH(5)) GRID_BAR();
    }

    if (IN(6)) {
        const int gw = F.vcu * NWAVES + F.wave, NGW = F.G * NWAVES;
        for (int m = gw; m < T; m += NGW) ln_row(WSP(float, WS_H) + (size_t)m * D, F.in[19], F.in[20], WSP(float, WS_H) + (size_t)m * D, WSP(bf16, WS_HB) + (size_t)m * D, F.lane, 1.0f);
        if (BOTH(6)) GRID_BAR();
    }

    if (IN(7)) { router_phase(F); if (BOTH(7)) GRID_BAR(); }

    if (IN(8) || IN(9)) {
        volatile LAS int* tb = (volatile LAS int*)(F.lds + MISC_OFF + 256);
        __syncthreads();
        if (F.tid == 0) { const unsigned* cnt = ctl + CW_CNT; int acc = 0;
            for (int e = 0; e < 32; ++e) { const int c = (int)__hip_atomic_load(cnt + e, RLX_AGENT); tb[e] = c; tb[32 + e] = acc; acc += (c + 255) >> 8; }
            tb[64] = acc; }
        __syncthreads();
        if (IN(8)) {
            MoeSched<8, true> S; S.tb = tb; S.list = WSP(int, WS_RT); S.G = F.G; S.c = bx; S.lda = 1024; S.ldb = 1024; S.bstride = (size_t)2048 * 1024 * 2;
            pg8::Gemm g{WSP(bf16, WS_HB), WSP(bf16, WS_WGU), 1024, 1024, 1024};
            EpiSwiglu E{WSP(bf16, WS_ACT), WSP(float, WS_BGU), S}; pg8::gemm_phase(F.lds, g, S, E);
            if (BOTH(8)) GRID_BAR();
        }
        if (IN(9)) {
            MoeSched<4, false> S; S.tb = tb; S.list = WSP(int, WS_RT); S.G = F.G; S.c = bx; S.lda = 1024; S.ldb = 1024; S.bstride = (size_t)1024 * 1024 * 2;
            pg8::Gemm g{WSP(bf16, WS_ACT), WSP(bf16, WS_WDN), 1024, 1024, 1024};
            EpiDown E{WSP(bf16, WS_YB), F.in[26], WSP(float, WS_TOPW), WSP(int, WS_RT), S}; pg8::gemm_phase(F.lds, g, S, E);
            if (BOTH(9)) GRID_BAR();
        }
    }

    if (IN(10)) final_phase(F);
#undef IN
#undef BOTH
}

extern "C" void kernel_launch(void* const* d_in, const int* in_sizes, int n_in, void* d_out, int out_size, void* d_ws, size_t ws_size, hipStream_t stream) {
    static int grid = 0;
    if (grid == 0) {
        if (n_in != 29 || out_size != T * D || ws_size < WS_END) { fprintf(stderr, "kernel_launch: unexpected shapes (n_in %d out %d ws %zu need %zu)\n", n_in, out_size, ws_size, (size_t)WS_END); grid = -1; return; }
        int dev = 0, cus = 0, per_cu = 0;
        if (hipGetDevice(&dev) != hipSuccess || hipDeviceGetAttribute(&cus, hipDeviceAttributeMultiprocessorCount, dev) != hipSuccess) { grid = -1; return; }
        if (hipFuncSetAttribute((const void*)mega_fwd, hipFuncAttributeMaxDynamicSharedMemorySize, LDS_BYTES) != hipSuccess) { fprintf(stderr, "kernel_launch: hipFuncSetAttribute failed\n"); grid = -1; return; }
        if (hipOccupancyMaxActiveBlocksPerMultiprocessor(&per_cu, (const void*)mega_fwd, NWAVES * 64, LDS_BYTES) != hipSuccess || per_cu < 1) fprintf(stderr, "kernel_launch: occupancy query says %d\n", per_cu);
        (void)hipGetLastError();
        grid = cus;
    }
    if (grid < 0) return;
    (void)in_sizes;
    if (hipMemsetAsync((char*)d_ws + WS_CTL, 0, CTL_ZERO_BYTES, stream) != hipSuccess) return;
    Args a{};
    for (int i = 0; i < 29; ++i) a.in[i] = (const float*)d_in[i];
    a.out = (float*)d_out; a.ws = (unsigned char*)d_ws;
#if MK_PER_PHASE
    for (int p = 0; p < N_PHASES; ++p) { a.ph_lo = p; a.ph_hi = p + 1; a.li = p; hipLaunchKernelGGL(mega_fwd, dim3(grid), dim3(NWAVES * 64), LDS_BYTES, stream, a); }
#else
    a.ph_lo = 0; a.ph_hi = N_PHASES; a.li = 0;
    hipLaunchKernelGGL(mega_fwd, dim3(grid), dim3(NWAVES * 64), LDS_BYTES, stream, a);
#endif
}
```

```cpp
#include <hip/hip_runtime.h>
#include <cstdio>
#include <cstdint>

#ifndef MK_PER_PHASE
#define MK_PER_PHASE 0
#endif

namespace pg8 {
#define PG8_LAS __attribute__((address_space(3)))
typedef unsigned short bf16_t;
typedef short bf16x8 __attribute__((ext_vector_type(8)));
typedef float f32x4 __attribute__((ext_vector_type(4)));
typedef float f32x2 __attribute__((ext_vector_type(2)));
typedef unsigned u32x4 __attribute__((ext_vector_type(4)));
typedef unsigned u32x2 __attribute__((ext_vector_type(2)));
constexpr int BM = 256, BK = 64, HALF = 128, HTB = HALF * BK * 2, STAGE_BYTES = 8 * HTB, NXCD = 8, WGM = 8;

__host__ __device__ __forceinline__ int lds_byte(int r, int c) { const int st = (r >> 4) * 2 + (c >> 5), rr = r & 15, cc = c & 31, ob = rr * 64 + cc * 2; return st * 1024 + (ob ^ (((ob >> 9) & 1) << 5)); }
__host__ __device__ __forceinline__ void stage_rc(int b, int& R, int& C) { const int st = b / 1024, sb = b % 1024, swz = sb ^ (((sb >> 9) & 1) << 5); R = (st >> 1) * 16 + swz / 64; C = (st & 1) * 32 + (swz % 64) / 2; }
__host__ __device__ __forceinline__ int perm32(int rho) { const int n = rho >> 4, i = rho & 15; return 8 * (i >> 2) + 4 * n + (i & 3); }

struct Unit { int pm, pn, z; };
struct Gemm { const bf16_t* A; const bf16_t* Bt; int lda, ldb, K; };

struct StaticOrder {
    static constexpr bool GATHER = false;
    int nM, nN, nwg, G, c, nz; size_t az, bz;
    int lda, ldb;
    __device__ void init(int M, int N, int G_, int c_, int lda_, int ldb_, int nz_ = 1, size_t az_ = 0, size_t bz_ = 0) { nM = M / BM; nN = N / BM; nwg = nM * nN; G = G_; c = c_; nz = nz_; az = az_; bz = bz_; lda = lda_; ldb = ldb_; }
    __device__ bool next(int i, Unit& u) const {
        const long L = (long)i * G + c; if (c < 0 || L >= (long)nwg * nz) return false;
        int wgid = (int)(L % nwg); u.z = (int)(L / nwg);
        { const int q = nwg / NXCD, r = nwg % NXCD, xcd = wgid % NXCD, off = wgid / NXCD; wgid = (xcd < r ? xcd * (q + 1) : r * (q + 1) + (xcd - r) * q) + off; }
        const int nig = WGM * nN, gid = wgid / nig, fm = gid * WGM, gsz = (nM - fm) < WGM ? (nM - fm) : WGM;
        u.pm = fm + ((wgid % nig) % gsz); u.pn = (wgid % nig) / gsz; return true;
    }
    __device__ __forceinline__ size_t a_off(const Unit& u) const { return (size_t)u.z * az + (size_t)u.pm * BM * lda * 2; }
    __device__ __forceinline__ size_t b_off(const Unit& u) const { return (size_t)u.z * bz + (size_t)u.pn * BM * ldb * 2; }
    __device__ __forceinline__ unsigned gather_row(const Unit&, int) const { return 0u; }
};

__device__ __forceinline__ unsigned cvt_pk_bf16(float lo, float hi) { unsigned r; asm volatile("v_cvt_pk_bf16_f32 %0, %1, %2" : "=v"(r) : "v"(lo), "v"(hi)); return r; }

template <class Epi, class Sched>
__device__ __forceinline__ void gemm_phase(PG8_LAS unsigned char* lds, const Gemm g, const Sched& S, const Epi& E) {
    constexpr bool GA = Sched::GATHER;
    const int tid = threadIdx.x, wid = __builtin_amdgcn_readfirstlane(tid >> 6), lane = tid & 63, wr = wid >> 2, wc = wid & 3, fr = lane & 15, fq = lane >> 4;
    const int K = g.K, nt = K / BK;
    unsigned voffA[2], voffB[2]; int RA[2], CA[2];
#pragma unroll
    for (int i = 0; i < 2; ++i) { int R, C; stage_rc(tid * 16 + i * 8192, R, C); const int Rb = Epi::PERM ? ((R & ~31) + perm32(R & 31)) : R;
        RA[i] = R; CA[i] = C; voffA[i] = (unsigned)(R * g.lda + C) * 2u; voffB[i] = (unsigned)(Rb * g.ldb + C) * 2u; }
    const size_t kstep = (size_t)(BK * 2);
    const size_t hstepA = GA ? 0 : (size_t)HALF * g.lda * 2, hstepB = (size_t)HALF * g.ldb * 2;
    const unsigned ldsw = (unsigned)wid * 1024u;
    const int aoff = lds_byte(wr * 64 + fr, fq * 8), boff = lds_byte(wc * 32 + fr, fq * 8);
    unsigned vgc[2][2], vgn[2][2];
#define PG8_SA(b, h) (((b) * 2 + (h)) * HTB)
#define PG8_SB(b, h) ((4 + (b) * 2 + (h)) * HTB)
#define PG8_STAGE(bufoff, gbase, voff) do { _Pragma("unroll") for (int _i = 0; _i < 2; ++_i) \
        __builtin_amdgcn_global_load_lds((const unsigned*)((const char*)(gbase) + (voff)[_i]), (PG8_LAS unsigned*)(lds + (bufoff) + ldsw + _i * 8192), 16, 0, 0); } while (0)
#define PG8_STAGE_A(bufoff, gbase, h, nx) do { if constexpr (GA) { unsigned _v[2]; _v[0] = (nx) ? vgn[h][0] : vgc[h][0]; _v[1] = (nx) ? vgn[h][1] : vgc[h][1]; PG8_STAGE(bufoff, gbase, _v); } \
        else { PG8_STAGE(bufoff, (gbase) + (h) * hstepA, voffA); } } while (0)
#define PG8_LDA(dst, b, h) do { _Pragma("unroll") for (int m = 0; m < 4; ++m) _Pragma("unroll") for (int k = 0; k < 2; ++k) dst[m][k] = *(const PG8_LAS bf16x8*)(lds + PG8_SA(b, h) + aoff + m * 2048 + k * 1024); } while (0)
#define PG8_LDB(dst, b, h) do { _Pragma("unroll") for (int n = 0; n < 2; ++n) _Pragma("unroll") for (int k = 0; k < 2; ++k) dst[n][k] = *(const PG8_LAS bf16x8*)(lds + PG8_SB(b, h) + boff + n * 2048 + k * 1024); } while (0)
#define PG8_MMA(ai, bj, At, Bt) do { __builtin_amdgcn_s_setprio(1); _Pragma("unroll") for (int m = 0; m < 4; ++m) _Pragma("unroll") for (int n = 0; n < 2; ++n) _Pragma("unroll") for (int k = 0; k < 2; ++k) \
        acc[ai][bj][m][n] = __builtin_amdgcn_mfma_f32_16x16x32_bf16(Bt[n][k], At[m][k], acc[ai][bj][m][n], 0, 0, 0); __builtin_amdgcn_s_setprio(0); } while (0)
#define PG8_WAIT_V(n) asm volatile("s_waitcnt vmcnt(" #n ")" ::: "memory")
#define PG8_WAIT_L(n) asm volatile("s_waitcnt lgkmcnt(" #n ")" ::: "memory")
#define PG8_BAR __builtin_amdgcn_s_barrier()
#define PG8_SCHED __builtin_amdgcn_sched_barrier(0)
    Unit cur, nxt; int ui = 0;
    if (!S.next(0, cur)) return;
    f32x4 acc[2][2][4][2];
#pragma unroll
    for (int a = 0; a < 2; ++a)
#pragma unroll
        for (int b = 0; b < 2; ++b)
#pragma unroll
            for (int m = 0; m < 4; ++m)
#pragma unroll
                for (int n = 0; n < 2; ++n) acc[a][b][m][n] = (f32x4){0.f, 0.f, 0.f, 0.f};
    bf16x8 At[4][2], B0[2][2], B1[2][2];
    const char* cA = (const char*)g.A + (GA ? 0 : S.a_off(cur)); const char* cB = (const char*)g.Bt + S.b_off(cur);
    if constexpr (GA) {
#pragma unroll
        for (int h = 0; h < 2; ++h)
#pragma unroll
            for (int i = 0; i < 2; ++i) { vgc[h][i] = S.gather_row(cur, h * HALF + RA[i]) + (unsigned)CA[i] * 2u; vgn[h][i] = vgc[h][i]; }
    }
    PG8_STAGE(PG8_SB(0, 0), cB, voffB); PG8_STAGE(PG8_SB(0, 1), cB + hstepB, voffB); PG8_STAGE_A(PG8_SA(0, 0), cA, 0, false); PG8_STAGE_A(PG8_SA(0, 1), cA, 1, false);
    if (wr == 1) PG8_BAR;
    PG8_WAIT_V(2); PG8_BAR;
    PG8_STAGE(PG8_SB(1, 0), cB + kstep, voffB); PG8_STAGE_A(PG8_SA(1, 0), cA + kstep, 0, false); PG8_STAGE(PG8_SB(1, 1), cB + hstepB + kstep, voffB);
    PG8_WAIT_V(6); PG8_BAR;
    for (;;) {
        const bool has_next = S.next(ui + 1, nxt);
        const char* nA = has_next ? (const char*)g.A + (GA ? 0 : S.a_off(nxt)) : cA; const char* nB = has_next ? (const char*)g.Bt + S.b_off(nxt) : cB;
        if constexpr (GA) { if (has_next) {
#pragma unroll
            for (int h = 0; h < 2; ++h)
#pragma unroll
                for (int i = 0; i < 2; ++i) vgn[h][i] = S.gather_row(nxt, h * HALF + RA[i]) + (unsigned)CA[i] * 2u; } }
        for (int t = 0; t < nt; t += 2) {
            const bool last = (t == nt - 2);
            const char* a1 = cA + (size_t)(t + 1) * kstep;
            const char* a2 = last ? nA : cA + (size_t)(t + 2) * kstep; const char* b2 = last ? nB : cB + (size_t)(t + 2) * kstep;
            const char* a3 = a2 + kstep; const char* b3 = b2 + kstep;
            PG8_LDB(B0, 0, 0); PG8_LDB(B1, 0, 1); PG8_SCHED; PG8_LDA(At, 0, 0); PG8_STAGE_A(PG8_SA(1, 1), a1, 1, false);
            PG8_WAIT_V(8); PG8_WAIT_L(0); PG8_BAR; PG8_MMA(0, 0, At, B0); PG8_MMA(0, 1, At, B1); PG8_BAR; PG8_SCHED;
            PG8_LDA(At, 0, 1); PG8_STAGE(PG8_SB(0, 0), b2, voffB); PG8_STAGE(PG8_SB(0, 1), b2 + hstepB, voffB); PG8_STAGE_A(PG8_SA(0, 0), a2, 0, last);
            PG8_WAIT_V(8); PG8_WAIT_L(0); PG8_BAR; PG8_MMA(1, 0, At, B0); PG8_MMA(1, 1, At, B1); PG8_BAR; PG8_SCHED;
            PG8_LDB(B0, 1, 0); PG8_LDB(B1, 1, 1); PG8_SCHED; PG8_LDA(At, 1, 0); PG8_STAGE_A(PG8_SA(0, 1), a2, 1, last);
            PG8_WAIT_V(8); PG8_WAIT_L(0); PG8_BAR; PG8_MMA(0, 0, At, B0); PG8_MMA(0, 1, At, B1); PG8_BAR; PG8_SCHED;
            PG8_LDA(At, 1, 1); PG8_STAGE(PG8_SB(1, 0), b3, voffB); PG8_STAGE(PG8_SB(1, 1), b3 + hstepB, voffB); PG8_STAGE_A(PG8_SA(1, 0), a3, 0, last);
            PG8_WAIT_V(8); PG8_WAIT_L(0); PG8_BAR; PG8_MMA(1, 0, At, B0); PG8_MMA(1, 1, At, B1); PG8_BAR; PG8_SCHED;
        }
        if (wr == 0) PG8_BAR;
        E(acc, cur, wr, wc, fr, fq);
        if (!has_next) break;
#pragma unroll
        for (int a = 0; a < 2; ++a)
#pragma unroll
            for (int b = 0; b < 2; ++b)
#pragma unroll
                for (int m = 0; m < 4; ++m)
#pragma unroll
                    for (int n = 0; n < 2; ++n) acc[a][b][m][n] = (f32x4){0.f, 0.f, 0.f, 0.f};
        cur = nxt; cA = nA; cB = nB; ++ui;
        if constexpr (GA) {
#pragma unroll
            for (int h = 0; h < 2; ++h)
#pragma unroll
                for (int i = 0; i < 2; ++i) vgc[h][i] = vgn[h][i]; }
        if (wr == 1) PG8_BAR;
    }
    PG8_WAIT_V(0);
    PG8_BAR;
#undef PG8_SA
#undef PG8_SB
#undef PG8_STAGE
#undef PG8_STAGE_A
#undef PG8_LDA
#undef PG8_LDB
#undef PG8_MMA
#undef PG8_WAIT_V
#undef PG8_WAIT_L
#undef PG8_BAR
#undef PG8_SCHED
}
}

constexpr int NWAVES = 8;
constexpr int T = 16384, D = 1024, NB = 4, SEQ = 4096, NP = 6912, MEM = 256;
constexpr int Q_OFF = 0, K_OFF = 512, V_OFF = 1024, R_OFF = 2048, MQ_OFF = 3072, G_OFF = 3584, LR_OFF = 6656;
constexpr int IN_W = 7200, LR_SRC = 3072, FN_SRC = 3104, MQ_SRC = 3616, G_SRC = 4128;
constexpr int NE = 32, DFF = 1024, ACT_ROWS = 73728;
constexpr float LN_EPS = 1e-5f, RMS_EPS = 1e-6f;
constexpr float DN_ALPHA = 1.18920711500272f;
constexpr int N_PHASES = 12;

constexpr size_t MiB = 1u << 20;
constexpr size_t WS_CTL = 0, CTL_ZERO_BYTES = 1 * MiB;
constexpr size_t WS_WIN = 1 * MiB;
constexpr size_t WS_WZ = 15 * MiB;
constexpr size_t WS_WKV = 17 * MiB;
constexpr size_t WS_WGLA = 19 * MiB;
constexpr size_t WS_WFN = 21 * MiB;
constexpr size_t WS_WMEM = 22 * MiB;
constexpr size_t WS_WOUT = 23 * MiB;
constexpr size_t WS_WRT = 25 * MiB;
constexpr size_t WS_BIN = WS_WRT + 65536;
constexpr size_t WS_BZ = WS_BIN + 32768;
constexpr size_t WS_BGU = WS_BZ + 4096;
constexpr size_t WS_WGU = 26 * MiB;
constexpr size_t WS_WDN = 154 * MiB;
constexpr size_t WS_H = 218 * MiB;
constexpr size_t WS_HB = 282 * MiB;
constexpr size_t WS_MEMN = 314 * MiB;
constexpr size_t WS_KV = 316 * MiB;
constexpr size_t WS_RT = 318 * MiB;
constexpr size_t WS_TOPW = WS_RT + 2 * MiB;
constexpr size_t WS_PROJ = 321 * MiB;
constexpr size_t WS_ZT = 537 * MiB;
constexpr size_t WS_DFT = 569 * MiB;
constexpr size_t WS_ACT = 321 * MiB;
constexpr size_t WS_YB = 465 * MiB;
constexpr size_t WS_OF = 633 * MiB;
constexpr size_t WS_OB = 665 * MiB;
constexpr size_t WS_OI = 697 * MiB;
constexpr size_t WS_QIN = 729 * MiB;
constexpr size_t WS_OG = 761 * MiB;
constexpr size_t WS_F = 793 * MiB;
constexpr size_t WS_OM = 809 * MiB;
constexpr size_t WS_MG = 825 * MiB;
constexpr size_t WS_MGB = 889 * MiB;
constexpr size_t WS_KST = 921 * MiB;
constexpr size_t WS_VT = 953 * MiB;
constexpr size_t WS_DD = 985 * MiB;
constexpr size_t WS_END = 986 * MiB;
constexpr int CW_TMO = 0, CW_BAR = 4096, CW_CNT = 16384;

constexpr int RING_BYTES = 131072, LDSCTL_OFF = 135168, MISC_OFF = LDSCTL_OFF + 1024, LDS_BYTES = 147456;

#define GAS __attribute__((address_space(1)))
#define LAS __attribute__((address_space(3)))
typedef unsigned short bf16;
typedef unsigned v4u __attribute__((ext_vector_type(4)));
typedef unsigned v2u __attribute__((ext_vector_type(2)));
typedef float f32x4 __attribute__((ext_vector_type(4)));
typedef short bf16x8 __attribute__((ext_vector_type(8)));
typedef GAS unsigned gu32;
#define RLX_AGENT __ATOMIC_RELAXED, __HIP_MEMORY_SCOPE_AGENT
#define LDS_WAIT() asm volatile("s_waitcnt lgkmcnt(0)" ::: "memory")
#define VM_WAIT() asm volatile("s_waitcnt vmcnt(0)" ::: "memory")
__device__ __forceinline__ unsigned f2bf(float f) { unsigned u = __builtin_bit_cast(unsigned, f); return (u + 0x7fffu + ((u >> 16) & 1u)) >> 16; }
__device__ __forceinline__ unsigned pk2(float lo, float hi) { return f2bf(lo) | (f2bf(hi) << 16); }
__device__ __forceinline__ float bf2f(unsigned b) { return __builtin_bit_cast(float, b << 16); }
__device__ __forceinline__ float bflo(unsigned w) { return __builtin_bit_cast(float, w << 16); }
__device__ __forceinline__ float bfhi(unsigned w) { return __builtin_bit_cast(float, w & 0xffff0000u); }

#define XB_TMO      128
#define XB_XCNT(j)  (256  + 64 * (j))
#define XB_XSUB(j)  (1280 + 64 * (j))
#define XB_XGEN(j)  (2304 + 64 * (j))
#define XB_TOP      3328
#define XB_TOPGEN   3392
#define XCD_BAR_WORDS 3456
#define XB_SPIN_CAP (1u << 22)
__device__ __forceinline__ unsigned xb_ld(unsigned* p)              { return __hip_atomic_load(p, __ATOMIC_RELAXED, __HIP_MEMORY_SCOPE_AGENT); }
__device__ __forceinline__ unsigned xb_add(unsigned* p, unsigned v) { return __hip_atomic_fetch_add(p, v, __ATOMIC_RELAXED, __HIP_MEMORY_SCOPE_AGENT); }
__device__ __forceinline__ unsigned xb_xcc_id() { return (unsigned)__builtin_amdgcn_s_getreg((3 << 11) | 20) & 0xFu; }
#define XB_SPIN(cond, bar) do { unsigned _sp = 0; while (cond) { __builtin_amdgcn_s_sleep(1); \
    if ((++_sp & 255u) == 0u) { if (xb_ld(&(bar)[XB_TMO])) break; if (_sp > XB_SPIN_CAP) { atomicAdd(&(bar)[XB_TMO], 1u); break; } } } } while (0)
struct XcdBarrier { unsigned* bar; unsigned x; volatile LAS unsigned* st; };
__device__ __forceinline__ XcdBarrier xcd_barrier_post(unsigned* bar, volatile LAS unsigned* st) {
    XcdBarrier b; b.bar = bar; b.x = xb_xcc_id(); b.st = st;
    if (threadIdx.x == 0) (void)xb_add(&bar[XB_XCNT(b.x)], 1u);
    return b;
}
__device__ __forceinline__ void xcd_barrier_complete(unsigned* bar, unsigned x, unsigned& nloc, unsigned& nx) {
    const unsigned G = gridDim.x * gridDim.y * gridDim.z;
    unsigned sum, cnt, mine, sp = 0u;
    for (;;) {
        sum = 0u; cnt = 0u; mine = 0u;
#pragma unroll
        for (unsigned j = 0; j < 16; ++j) { const unsigned c = xb_ld(&bar[XB_XCNT(j)]); sum += c; cnt += (c > 0u) ? 1u : 0u; mine = (j == x) ? c : mine; }
        if (sum == G) break;
        __builtin_amdgcn_s_sleep(1);
        if ((++sp & 255u) == 0u) { if (xb_ld(&bar[XB_TMO])) break; if (sp > XB_SPIN_CAP) { atomicAdd(&bar[XB_TMO], 1u); break; } }
    }
    nloc = mine > 0u ? mine : 1u; nx = cnt > 0u ? cnt : 1u;
}
__device__ __forceinline__ void xcd_barrier(const XcdBarrier& b) {
    asm volatile("s_waitcnt vmcnt(0)" ::: "memory");
    __syncthreads();
    if (threadIdx.x == 0) {
        unsigned* bar = b.bar;
        __builtin_amdgcn_s_waitcnt(0);
        unsigned nloc = b.st[0], nx = b.st[1];
        if (nloc == 0u) { xcd_barrier_complete(bar, b.x, nloc, nx); b.st[0] = nloc; b.st[1] = nx; }
        const unsigned old = xb_add(&bar[XB_XSUB(b.x)], 1u);
        const unsigned gen = old / nloc;
        if (old + 1u == (gen + 1u) * nloc) {
            __builtin_amdgcn_fence(__ATOMIC_RELEASE, "agent");
            asm volatile("s_waitcnt vmcnt(0)" ::: "memory");
            const unsigned og = xb_add(&bar[XB_TOP], 1u);
            const unsigned tg = og / nx;
            if (og + 1u == (tg + 1u) * nx) xb_add(&bar[XB_TOPGEN], 1u);
            else XB_SPIN(xb_ld(&bar[XB_TOPGEN]) == tg, bar);
            __builtin_amdgcn_fence(__ATOMIC_ACQUIRE, "agent");
            xb_add(&bar[XB_XGEN(b.x)], 1u);
            asm volatile("s_waitcnt vmcnt(0)" ::: "memory");
        } else {
            XB_SPIN(xb_ld(&bar[XB_XGEN(b.x)]) == gen, bar);
            __builtin_amdgcn_fence(__ATOMIC_ACQUIRE, "agent");
            asm volatile("s_waitcnt vmcnt(0)" ::: "memory");
        }
    }
    __syncthreads();
}

struct Frame {
    LAS unsigned char* lds;
    int tid, lane, wave, vcu, G;
    const float* in[29];
    float* out;
    unsigned char* ws;
};
#define WSP(T_, off) ((T_*)(F.ws + (off)))
__device__ __forceinline__ float wave_sum(float v) {
#pragma unroll
    for (int o = 1; o < 64; o <<= 1) v += __shfl_xor(v, o);
    return v;
}
__device__ __forceinline__ float wave_max(float v) {
#pragma unroll
    for (int o = 1; o < 64; o <<= 1) v = fmaxf(v, __shfl_xor(v, o));
    return v;
}

__device__ __forceinline__ void p0_transpose_item(const float* W, int K, int N, int k0, int n0, bf16* WT, int dst_row0, LAS float* scr, int lane) {
#pragma unroll 8
    for (int i = 0; i < 32; ++i) { const int kk = 2 * i + (lane >> 5); scr[kk * 33 + (lane & 31)] = W[(size_t)(k0 + kk) * N + n0 + (lane & 31)]; }
    LDS_WAIT(); asm volatile("" ::: "memory");
    const int c = lane & 7;
#pragma unroll
    for (int j = 0; j < 4; ++j) { const int n = (lane >> 3) + 8 * j; const LAS float* s = scr + (8 * c) * 33 + n;
        v4u o; o.x = pk2(s[0 * 33], s[1 * 33]); o.y = pk2(s[2 * 33], s[3 * 33]); o.z = pk2(s[4 * 33], s[5 * 33]); o.w = pk2(s[6 * 33], s[7 * 33]);
        *(GAS v4u*)(WT + (size_t)(dst_row0 + n) * K + k0 + 8 * c) = o; }
    LDS_WAIT(); asm volatile("" ::: "memory");
}
__device__ __forceinline__ void ln_row(const float* xrow, const float* g, const float* b, float* of32, bf16* obf, int lane, float pre_scale) {
    const GAS f32x4* xr = (const GAS f32x4*)xrow + lane;
    f32x4 v[4]; float s = 0.f;
#pragma unroll
    for (int j = 0; j < 4; ++j) { v[j] = xr[64 * j] * pre_scale; s += (v[j].x + v[j].y) + (v[j].z + v[j].w); }
    const float mean = wave_sum(s) * (1.f / D); float s2 = 0.f;
#pragma unroll
    for (int j = 0; j < 4; ++j) { v[j] = v[j] - mean; s2 += (v[j].x * v[j].x + v[j].y * v[j].y) + (v[j].z * v[j].z + v[j].w * v[j].w); }
    const float rstd = 1.f / sqrtf(wave_sum(s2) * (1.f / D) + LN_EPS);
#pragma unroll
    for (int j = 0; j < 4; ++j) { const f32x4 gg = ((const GAS f32x4*)g)[lane + 64 * j], bb = ((const GAS f32x4*)b)[lane + 64 * j]; v[j] = v[j] * rstd * gg + bb; }
    if (of32) { GAS f32x4* o = (GAS f32x4*)of32 + lane;
#pragma unroll
        for (int j = 0; j < 4; ++j) o[64 * j] = v[j]; }
    if (obf) { GAS unsigned long long* o8 = (GAS unsigned long long*)obf + lane;
#pragma unroll
        for (int j = 0; j < 4; ++j) o8[64 * j] = (unsigned long long)pk2(v[j].x, v[j].y) | ((unsigned long long)pk2(v[j].z, v[j].w) << 32); }
}

__device__ __forceinline__ void p0_prologue(Frame& F) {
    LAS float* scr = (LAS float*)(F.lds + F.wave * 16384);
    const int gw = F.vcu * NWAVES + F.wave, NGW = F.G * NWAVES;
    const int gt = F.vcu * 512 + F.tid, NGT = F.G * 512;
    constexpr int I_IN = 16 * 225, I_GLA = 16 * 32, I_FN = 8 * 32, I_MEM = 8 * 32, I_KV = 16 * 32, I_OUT = 16 * 32, I_RT = 16, I_GU = 32 * 16 * 64, I_DN = 32 * 16 * 32;
    constexpr int NITEMS = I_IN + I_GLA + I_FN + I_MEM + I_KV + I_OUT + I_RT + I_GU + I_DN;
    for (int it = gw; it < NITEMS; it += NGW) {
        int r = it;
        if (r < I_IN) { const int kb = r / 225, nb = r % 225; int dst;
            if (nb < 96) dst = nb * 32; else if (nb == 96) dst = LR_OFF; else if (nb < 113) continue; else if (nb < 129) dst = nb * 32 - MQ_SRC + MQ_OFF; else dst = nb * 32 - G_SRC + G_OFF;
            p0_transpose_item(F.in[6], 1024, IN_W, 64 * kb, 32 * nb, WSP(bf16, WS_WIN), dst, scr, F.lane); continue; } r -= I_IN;
        if (r < I_GLA) { p0_transpose_item(F.in[13], 1024, 1024, 64 * (r / 32), 32 * (r % 32), WSP(bf16, WS_WGLA), 32 * (r % 32), scr, F.lane); continue; } r -= I_GLA;
        if (r < I_FN) { p0_transpose_item(F.in[14], 512, 1024, 64 * (r / 32), 32 * (r % 32), WSP(bf16, WS_WFN), 32 * (r % 32), scr, F.lane); continue; } r -= I_FN;
        if (r < I_MEM) { p0_transpose_item(F.in[15], 512, 1024, 64 * (r / 32), 32 * (r % 32), WSP(bf16, WS_WMEM), 32 * (r % 32), scr, F.lane); continue; } r -= I_MEM;
        if (r < I_KV) { p0_transpose_item(F.in[16], 1024, 1024, 64 * (r / 32), 32 * (r % 32), WSP(bf16, WS_WKV), 32 * (r % 32), scr, F.lane); continue; } r -= I_KV;
        if (r < I_OUT) { p0_transpose_item(F.in[17], 1024, 1024, 64 * (r / 32), 32 * (r % 32), WSP(bf16, WS_WOUT), 32 * (r % 32), scr, F.lane); continue; } r -= I_OUT;
        if (r < I_RT) { p0_transpose_item(F.in[21], 1024, 32, 64 * r, 0, WSP(bf16, WS_WRT), 0, scr, F.lane); continue; } r -= I_RT;
        if (r < I_GU) { const int e = r / 1024, q = r % 1024, kb = q / 64, nb = q % 64, j = nb * 32;
            const int dst = (j < 1024) ? (j / 128) * 256 + (j % 128) : ((j - 1024) / 128) * 256 + 128 + ((j - 1024) % 128);
            p0_transpose_item(F.in[23] + (size_t)e * 1024 * 2048, 1024, 2048, 64 * kb, j, WSP(bf16, WS_WGU) + (size_t)e * 2048 * 1024, dst, scr, F.lane); continue; } r -= I_GU;
        { const int e = r / 512, q = r % 512, kb = q / 32, nb = q % 32;
            p0_transpose_item(F.in[25] + (size_t)e * 1024 * 1024, 1024, 1024, 64 * kb, 32 * nb, WSP(bf16, WS_WDN) + (size_t)e * 1024 * 1024, 32 * nb, scr, F.lane); }
    }
    { bf16* w = WSP(bf16, WS_WIN) + (size_t)(LR_OFF + 32) * 1024; for (int i = gt; i < (NP - LR_OFF - 32) * 1024 / 8; i += NGT) ((GAS v4u*)w)[i] = (v4u){0u, 0u, 0u, 0u}; }
    { float* bp = WSP(float, WS_BIN); const float* b = F.in[7];
      for (int i = gt; i < NP; i += NGT) { float v = 0.f;
          if (i < 3072) v = b[i]; else if (i < G_OFF) v = b[i - MQ_OFF + MQ_SRC]; else if (i < LR_OFF) v = b[i - G_OFF + G_SRC]; else if (i < LR_OFF + 32) v = b[i - LR_OFF + LR_SRC];
          bp[i] = v; } }
    { float* bp = WSP(float, WS_BGU); const float* b = F.in[24];
      for (int i = gt; i < NE * 2048; i += NGT) { const int e = i / 2048, d = i % 2048, pn = d / 256, w = d % 256; const int src = (w < 128) ? pn * 128 + w : 1024 + pn * 128 + (w - 128); bp[i] = b[e * 2048 + src]; } }
    __syncthreads();
    { LAS float* t128 = (LAS float*)F.lds;
      if (F.tid < 128) { float sn, cs; sincospif((float)F.tid * (1.0f / 64.0f), &sn, &cs); t128[2 * F.tid] = cs; t128[2 * F.tid + 1] = sn; }
      __syncthreads();
      bf16* wz = WSP(bf16, WS_WZ); const float* w = F.in[6]; const float rs = 0.08838834764831845f;
      for (int idx = gt; idx < 1024 * 512; idx += NGT) { const int k = idx & 1023, gc = idx >> 10, g = gc >> 7, cp = gc & 127;
          const float* src = w + (size_t)k * IN_W + FN_SRC + g * 128; float ar = 0.f, ai = 0.f;
          for (int c4 = 0; c4 < 32; ++c4) { const f32x4 x = *(const GAS f32x4*)(src + 4 * c4);
#pragma unroll
              for (int j = 0; j < 4; ++j) { const int mm = ((4 * c4 + j) * cp) & 127; const float cs = t128[2 * mm], sn = t128[2 * mm + 1]; ar += x[j] * cs; ai -= x[j] * sn; } }
          wz[(size_t)(gc * 2 + 0) * 1024 + k] = (bf16)f2bf(ar * rs); wz[(size_t)(gc * 2 + 1) * 1024 + k] = (bf16)f2bf(ai * rs); }
      float* bz = WSP(float, WS_BZ); const float* b = F.in[7];
      for (int gc = gt; gc < 512; gc += NGT) { const int g = gc >> 7, cp = gc & 127; float ar = 0.f, ai = 0.f;
          for (int c = 0; c < 128; ++c) { const int mm = (c * cp) & 127; const float cs = t128[2 * mm], sn = t128[2 * mm + 1]; const float x = b[FN_SRC + g * 128 + c]; ar += x * cs; ai -= x * sn; }
          bz[gc * 2] = ar * rs; bz[gc * 2 + 1] = ai * rs; } }
    __syncthreads();
    { LAS unsigned* tab = (LAS unsigned*)F.lds;
      for (int m = F.tid; m < 4096; m += 512) { float sn, cs; sincospif((float)m * (1.0f / 2048.0f), &sn, &cs); tab[m] = pk2(cs, sn); }
      __syncthreads();
      bf16* dft = WSP(bf16, WS_DFT);
      for (int idx = gt; idx < 4096 * 512; idx += NGT) { const int sp = idx >> 9, s0 = (idx & 511) * 8; unsigned cw[4], sw[4];
#pragma unroll
          for (int j = 0; j < 4; ++j) { const unsigned a = tab[((s0 + 2 * j) * sp) & 4095], b = tab[((s0 + 2 * j + 1) * sp) & 4095]; cw[j] = (a & 0xffffu) | (b << 16); sw[j] = (a >> 16) | (b & 0xffff0000u); }
          *(GAS v4u*)(dft + (size_t)sp * 8192 + s0) = (v4u){cw[0], cw[1], cw[2], cw[3]}; *(GAS v4u*)(dft + (size_t)sp * 8192 + 4096 + s0) = (v4u){sw[0], sw[1], sw[2], sw[3]}; }
      __syncthreads(); }
    for (int m = gw; m < T; m += NGW) ln_row(F.in[0] + (size_t)m * D, F.in[2], F.in[3], WSP(float, WS_H) + (size_t)m * D, WSP(bf16, WS_HB) + (size_t)m * D, F.lane, 1.0f);
    for (int m = gw; m < NB * MEM; m += NGW) ln_row(F.in[1] + (size_t)m * D, F.in[4], F.in[5], nullptr, WSP(bf16, WS_MEMN) + (size_t)m * D, F.lane, 1.0f);
}

using pg8::Unit; using pg8::cvt_pk_bf16;
struct EpiBias {
    static constexpr bool PERM = true;
    bf16* O; int ldc; const float* bias;
    __device__ __forceinline__ void operator()(const f32x4 (&acc)[2][2][4][2], const Unit& u, int wr, int wc, int fr, int fq) const {
        const int row0 = u.pm * 256 + wr * 64 + fr, col0 = u.pn * 256 + wc * 32 + 8 * fq;
        f32x4 bv[2][2];
#pragma unroll
        for (int bj = 0; bj < 2; ++bj)
#pragma unroll
            for (int n = 0; n < 2; ++n) bv[bj][n] = bias ? *(const f32x4*)(bias + col0 + bj * 128 + 4 * n) : (f32x4){0.f, 0.f, 0.f, 0.f};
#pragma unroll
        for (int ai = 0; ai < 2; ++ai)
#pragma unroll
            for (int m = 0; m < 4; ++m) { bf16* rowp = O + (size_t)(row0 + ai * 128 + m * 16) * ldc + col0;
#pragma unroll
                for (int bj = 0; bj < 2; ++bj) { const f32x4 v0 = acc[ai][bj][m][0] + bv[bj][0], v1 = acc[ai][bj][m][1] + bv[bj][1];
                    v4u w; w.x = cvt_pk_bf16(v0[0], v0[1]); w.y = cvt_pk_bf16(v0[2], v0[3]); w.z = cvt_pk_bf16(v1[0], v1[1]); w.w = cvt_pk_bf16(v1[2], v1[3]);
                    *(v4u*)(rowp + bj * 128) = w; } }
    }
};
struct EpiZT {
    static constexpr bool PERM = true;
    bf16* O; const float* bias;
    __device__ __forceinline__ void operator()(const f32x4 (&acc)[2][2][4][2], const Unit& u, int wr, int wc, int fr, int fq) const {
        const int row0 = u.pm * 256 + wr * 64 + fr, tok0 = u.pn * 256 + wc * 32 + 8 * fq, b = tok0 >> 12, s0 = tok0 & 4095;
#pragma unroll
        for (int ai = 0; ai < 2; ++ai)
#pragma unroll
            for (int m = 0; m < 4; ++m) { const int row = row0 + ai * 128 + m * 16; const float bz = bias[row]; bf16* rowp = O + ((size_t)b * 1024 + row) * 4096 + s0;
#pragma unroll
                for (int bj = 0; bj < 2; ++bj) { const f32x4 v0 = acc[ai][bj][m][0] + bz, v1 = acc[ai][bj][m][1] + bz;
                    v4u w; w.x = cvt_pk_bf16(v0[0], v0[1]); w.y = cvt_pk_bf16(v0[2], v0[3]); w.z = cvt_pk_bf16(v1[0], v1[1]); w.w = cvt_pk_bf16(v1[2], v1[3]);
                    *(v4u*)(rowp + bj * 128) = w; } }
    }
};
struct EpiFnet {
    static constexpr bool PERM = true;
    bf16* O;
    __device__ __forceinline__ void operator()(const f32x4 (&acc)[2][2][4][2], const Unit& u, int wr, int wc, int fr, int fq) const {
        const int row0 = u.z * 4096 + u.pm * 256 + wr * 64 + fr, col0 = u.pn * 256 + wc * 32 + 8 * fq;
#pragma unroll
        for (int ai = 0; ai < 2; ++ai)
#pragma unroll
            for (int m = 0; m < 4; ++m) { bf16* rowp = O + (size_t)(row0 + ai * 128 + m * 16) * 512 + col0;
#pragma unroll
                for (int bj = 0; bj < 2; ++bj) { const f32x4 v0 = acc[ai][bj][m][0] * 0.015625f, v1 = acc[ai][bj][m][1] * 0.015625f;
                    v4u w; w.x = cvt_pk_bf16(v0[0], v0[1]); w.y = cvt_pk_bf16(v0[2], v0[3]); w.z = cvt_pk_bf16(v1[0], v1[1]); w.w = cvt_pk_bf16(v1[2], v1[3]);
                    *(v4u*)(rowp + bj * 128) = w; } }
    }
};
template <int MODE> struct EpiGate {
    static constexpr bool PERM = true;
    float* MG; bf16* MGB; const bf16* gate;
    __device__ __forceinline__ void operator()(const f32x4 (&acc)[2][2][4][2], const Unit& u, int wr, int wc, int fr, int fq) const {
        const int row0 = u.pm * 256 + wr * 64 + fr, col0 = u.pn * 256 + wc * 32 + 8 * fq;
#pragma unroll
        for (int ai = 0; ai < 2; ++ai)
#pragma unroll
            for (int m = 0; m < 4; ++m) { const size_t row = (size_t)(row0 + ai * 128 + m * 16);
#pragma unroll
                for (int bj = 0; bj < 2; ++bj) { const int col = col0 + bj * 128;
                    const v4u gw = *(const v4u*)(gate + row * NP + col);
                    float gs[8] = {bflo(gw.x), bfhi(gw.x), bflo(gw.y), bfhi(gw.y), bflo(gw.z), bfhi(gw.z), bflo(gw.w), bfhi(gw.w)};
#pragma unroll
                    for (int j = 0; j < 8; ++j) gs[j] = 1.0f / (1.0f + __expf(-gs[j]));
                    f32x4 v0 = acc[ai][bj][m][0] * (f32x4){gs[0], gs[1], gs[2], gs[3]}, v1 = acc[ai][bj][m][1] * (f32x4){gs[4], gs[5], gs[6], gs[7]};
                    float* mp = MG + row * 1024 + col;
                    if (MODE >= 1) { v0 += *(const f32x4*)mp; v1 += *(const f32x4*)(mp + 4); }
                    if (MODE <= 1) { *(f32x4*)mp = v0; *(f32x4*)(mp + 4) = v1; }
                    else { v4u w; w.x = cvt_pk_bf16(v0[0], v0[1]); w.y = cvt_pk_bf16(v0[2], v0[3]); w.z = cvt_pk_bf16(v1[0], v1[1]); w.w = cvt_pk_bf16(v1[2], v1[3]); *(v4u*)(MGB + row * 1024 + col) = w; } } }
    }
};
struct EpiOut {
    static constexpr bool PERM = false;
    float* H; const float* bias;
    __device__ __forceinline__ void operator()(const f32x4 (&acc)[2][2][4][2], const Unit& u, int wr, int wc, int fr, int fq) const {
        const int row0 = u.pm * 256 + wr * 64 + fr, col0 = u.pn * 256 + wc * 32 + 4 * fq;
        f32x4 bv[2][2];
#pragma unroll
        for (int bj = 0; bj < 2; ++bj)
#pragma unroll
            for (int n = 0; n < 2; ++n) bv[bj][n] = *(const f32x4*)(bias + col0 + bj * 128 + n * 16);
#pragma unroll
        for (int ai = 0; ai < 2; ++ai)
#pragma unroll
            for (int m = 0; m < 4; ++m) { float* rowp = H + (size_t)(row0 + ai * 128 + m * 16) * 1024 + col0;
#pragma unroll
                for (int bj = 0; bj < 2; ++bj)
#pragma unroll
                    for (int n = 0; n < 2; ++n) { float* p = rowp + bj * 128 + n * 16; const f32x4 hv = *(const f32x4*)p; *(f32x4*)p = hv * DN_ALPHA + acc[ai][bj][m][n] + bv[bj][n]; } }
    }
};

template <int NPN, bool GATHER_> struct MoeSched {
    static constexpr bool GATHER = GATHER_;
    volatile LAS int* tb;
    const int* list;
    int G, c; int lda, ldb; size_t bstride;
    __device__ __forceinline__ bool next(int i, Unit& u) const {
        const int L = i * G + c, total = tb[64] * NPN; if (L >= total) return false;
        const int tl = L / NPN; int e = 0;
        for (int j = 1; j < 32; ++j) e += (tb[32 + j] <= tl) ? 1 : 0;
        const int te = tb[32 + e + 1] - tb[32 + e], idx = L - tb[32 + e] * NPN;
        u.z = e; u.pm = idx % te; u.pn = idx / te; return true;
    }
    __device__ __forceinline__ size_t a_off(const Unit& u) const { return (size_t)(tb[32 + u.z] + u.pm) * 256 * lda * 2; }
    __device__ __forceinline__ size_t b_off(const Unit& u) const { return (size_t)u.z * bstride + (size_t)u.pn * 256 * ldb * 2; }
    __device__ __forceinline__ unsigned gather_row(const Unit& u, int r) const {
        const int rr = u.pm * 256 + r; int tok = 0; if (rr < tb[u.z]) tok = list[u.z * T + rr] >> 2;
        return (unsigned)tok * (unsigned)(lda * 2);
    }
    __device__ __forceinline__ int row_base(const Unit& u) const { return (tb[32 + u.z] + u.pm) * 256; }
    __device__ __forceinline__ int nvalid(const Unit& u) const { return tb[u.z] - u.pm * 256; }
};
struct EpiSwiglu {
    static constexpr bool PERM = true;
    bf16* ACT; const float* bgu; MoeSched<8, true> S;
    __device__ __forceinline__ void operator()(const f32x4 (&acc)[2][2][4][2], const Unit& u, int wr, int wc, int fr, int fq) const {
        const int rbase = S.row_base(u) + wr * 64 + fr, cw = wc * 32 + 8 * fq;
        const float* bp = bgu + u.z * 2048 + u.pn * 256 + cw;
        const f32x4 bg0 = *(const f32x4*)bp, bg1 = *(const f32x4*)(bp + 4), bu0 = *(const f32x4*)(bp + 128), bu1 = *(const f32x4*)(bp + 132);
#pragma unroll
        for (int ai = 0; ai < 2; ++ai)
#pragma unroll
            for (int m = 0; m < 4; ++m) { const size_t row = (size_t)(rbase + ai * 128 + m * 16);
                float o[8];
#pragma unroll
                for (int n = 0; n < 2; ++n) { const f32x4 gt = acc[ai][0][m][n] + (n ? bg1 : bg0), up = acc[ai][1][m][n] + (n ? bu1 : bu0);
#pragma unroll
                    for (int j = 0; j < 4; ++j) { const float gg = fminf(gt[j], 7.0f), uu = fminf(fmaxf(up[j], -7.0f), 7.0f); o[4 * n + j] = (uu + 1.0f) * gg / (1.0f + __expf(-1.702f * gg)); } }
                v4u w; w.x = cvt_pk_bf16(o[0], o[1]); w.y = cvt_pk_bf16(o[2], o[3]); w.z = cvt_pk_bf16(o[4], o[5]); w.w = cvt_pk_bf16(o[6], o[7]);
                *(v4u*)(ACT + row * 1024 + u.pn * 128 + cw) = w; }
    }
};
struct EpiDown {
    static constexpr bool PERM = true;
    bf16* YB; const float* bd; const float* topw; const int* list; MoeSched<4, false> S;
    __device__ __forceinline__ void operator()(const f32x4 (&acc)[2][2][4][2], const Unit& u, int wr, int wc, int fr, int fq) const {
        const int nv = S.nvalid(u), col0 = u.pn * 256 + wc * 32 + 8 * fq;
        const float* bp = bd + u.z * 1024 + col0;
        f32x4 bv[2][2];
#pragma unroll
        for (int bj = 0; bj < 2; ++bj)
#pragma unroll
            for (int n = 0; n < 2; ++n) bv[bj][n] = *(const f32x4*)(bp + bj * 128 + 4 * n);
#pragma unroll
        for (int ai = 0; ai < 2; ++ai)
#pragma unroll
            for (int m = 0; m < 4; ++m) { const int r = ai * 128 + wr * 64 + m * 16 + fr;
                if (r < nv) { const int a = list[u.z * T + u.pm * 256 + r]; const float w = topw[a]; bf16* rowp = YB + (size_t)a * 1024 + col0;
#pragma unroll
                    for (int bj = 0; bj < 2; ++bj) { const f32x4 v0 = (acc[ai][bj][m][0] + bv[bj][0]) * w, v1 = (acc[ai][bj][m][1] + bv[bj][1]) * w;
                        v4u o; o.x = cvt_pk_bf16(v0[0], v0[1]); o.y = cvt_pk_bf16(v0[2], v0[3]); o.z = cvt_pk_bf16(v1[0], v1[1]); o.w = cvt_pk_bf16(v1[2], v1[3]);
                        *(v4u*)(rowp + bj * 128) = o; } } }
    }
};

typedef float f32x16 __attribute__((ext_vector_type(16)));
typedef float f32x2v __attribute__((ext_vector_type(2)));
typedef __bf16 bf16v2 __attribute__((ext_vector_type(2)));
__device__ __forceinline__ unsigned pkc(float lo, float hi) { return __builtin_bit_cast(unsigned, __builtin_convertvector((f32x2v){lo, hi}, bf16v2)); }
#define MFMA32(a, b, c) __builtin_amdgcn_mfma_f32_32x32x16_bf16((a), (b), (c), 0, 0, 0)
constexpr int G1_P = 272, G1_QF = 0, G1_KF = 17408, G1_QB = 34816, G1_KB = 52224, G1_VT = 69632, G1_VP = 144, G1_ATT = 106496, G1_LR = 115712, G1_TOT = 123904;
static_assert(G1_TOT + 8192 <= LDSCTL_OFF, "G1 LDS map");
__device__ __forceinline__ float logsig16(float z) { return (fminf(z, 0.f) - log1pf(__expf(-fabsf(z)))) * 0.0625f; }
__device__ __forceinline__ void gla_g1(Frame& F) {
    const bf16* proj = WSP(bf16, WS_PROJ);
    LAS unsigned char* L = F.lds;
    const int wave = F.wave;
    for (int unit = F.vcu; unit < 1024; unit += F.G) {
        int tid = F.tid; asm volatile("" : "+v"(tid));
        const int lane = tid & 63, l31 = lane & 31, hh = lane >> 5;
        const int n = unit & 63, bh = unit >> 6, h = bh & 3, b = bh >> 2;
        const size_t t0 = (size_t)b * SEQ + n * 64;
        __syncthreads();
        { const int row = tid >> 3, c4 = (tid & 7) * 4; const v2u w = *(const GAS v2u*)(proj + (t0 + row) * NP + LR_OFF + c4);
          LAS float* p = (LAS float*)(L + G1_LR) + row * 32 + c4; p[0] = bflo(w.x); p[1] = bfhi(w.x); p[2] = bflo(w.y); p[3] = bfhi(w.y); }
        { const int dvp = tid & 127, tg = tid >> 7; unsigned lo[8], hi[8];
#pragma unroll
          for (int t2 = 0; t2 < 8; ++t2) { const unsigned w0 = *(const GAS unsigned*)(proj + (t0 + 16 * tg + 2 * t2) * NP + V_OFF + h * 256 + 2 * dvp), w1 = *(const GAS unsigned*)(proj + (t0 + 16 * tg + 2 * t2 + 1) * NP + V_OFF + h * 256 + 2 * dvp);
              lo[t2] = (w0 & 0xffffu) | (w1 << 16); hi[t2] = (w0 >> 16) | (w1 & 0xffff0000u); }
          LAS unsigned char* p0 = L + G1_VT + (2 * dvp) * G1_VP + 32 * tg;
          *(LAS v4u*)p0 = (v4u){lo[0], lo[1], lo[2], lo[3]}; *(LAS v4u*)(p0 + 16) = (v4u){lo[4], lo[5], lo[6], lo[7]};
          *(LAS v4u*)(p0 + G1_VP) = (v4u){hi[0], hi[1], hi[2], hi[3]}; *(LAS v4u*)(p0 + G1_VP + 16) = (v4u){hi[4], hi[5], hi[6], hi[7]};
          bf16* vg = WSP(bf16, WS_VT) + ((size_t)bh * 64 + n) * 16384 + (2 * dvp) * 64 + 16 * tg;
          *(GAS v4u*)vg = (v4u){lo[0], lo[1], lo[2], lo[3]}; *(GAS v4u*)(vg + 8) = (v4u){lo[4], lo[5], lo[6], lo[7]};
          *(GAS v4u*)(vg + 64) = (v4u){hi[0], hi[1], hi[2], hi[3]}; *(GAS v4u*)(vg + 72) = (v4u){hi[4], hi[5], hi[6], hi[7]}; }
        __syncthreads();
        const int jp = tid & 63, ig = tid >> 6;
        float cf[8][2], cb[8][2];
#pragma unroll
        for (int dir = 0; dir < 2; ++dir) { const float* Wd = (dir ? F.in[10] : F.in[8]) + h * 128 + 2 * jp; const float* bd = (dir ? F.in[11] : F.in[9]) + h * 128 + 2 * jp;
            float w0[16], w1[16];
#pragma unroll
            for (int r = 0; r < 16; ++r) { const f32x2v w = *(const GAS f32x2v*)(Wd + r * 512); w0[r] = w.x; w1[r] = w.y; }
            const f32x2v bb = *(const GAS f32x2v*)bd;
#pragma unroll
            for (int rr = 0; rr < 8; ++rr) { const LAS f32x4* lr4 = (const LAS f32x4*)((LAS float*)(L + G1_LR) + (8 * ig + rr) * 32 + dir * 16); float z0 = bb.x, z1 = bb.y;
#pragma unroll
                for (int r4 = 0; r4 < 4; ++r4) { const f32x4 x = lr4[r4];
#pragma unroll
                    for (int j = 0; j < 4; ++j) { z0 += x[j] * w0[4 * r4 + j]; z1 += x[j] * w1[4 * r4 + j]; } }
                if (dir == 0) { cf[rr][0] = logsig16(z0); cf[rr][1] = logsig16(z1); } else { cb[rr][0] = logsig16(z0); cb[rr][1] = logsig16(z1); } }
        }
#pragma unroll
        for (int rr = 1; rr < 8; ++rr) { cf[rr][0] += cf[rr - 1][0]; cf[rr][1] += cf[rr - 1][1]; }
#pragma unroll
        for (int rr = 6; rr >= 0; --rr) { cb[rr][0] += cb[rr + 1][0]; cb[rr][1] += cb[rr + 1][1]; }
        { LAS float* tot = (LAS float*)(L + G1_TOT);
          *(LAS f32x2v*)(tot + (ig * 2 + 0) * 128 + 2 * jp) = (f32x2v){cf[7][0], cf[7][1]}; *(LAS f32x2v*)(tot + (ig * 2 + 1) * 128 + 2 * jp) = (f32x2v){cb[0][0], cb[0][1]}; }
        __syncthreads();
        float offf0 = 0.f, offf1 = 0.f, offb0 = 0.f, offb1 = 0.f, blf0 = 0.f, blf1 = 0.f, bb00 = 0.f, bb01 = 0.f;
        { const LAS float* tot = (const LAS float*)(L + G1_TOT);
#pragma unroll
          for (int g = 0; g < 8; ++g) { const f32x2v tf = *(const LAS f32x2v*)(tot + (g * 2 + 0) * 128 + 2 * jp), tb = *(const LAS f32x2v*)(tot + (g * 2 + 1) * 128 + 2 * jp);
              blf0 += tf.x; blf1 += tf.y; bb00 += tb.x; bb01 += tb.y;
              if (g < ig) { offf0 += tf.x; offf1 += tf.y; } if (g > ig) { offb0 += tb.x; offb1 += tb.y; } } }
        { const int blkf = ((bh * 2 + 0) * 64 + n), blkb = ((bh * 2 + 1) * 64 + n);
          bf16* qinf = WSP(bf16, WS_QIN) + (size_t)blkf * 8192; bf16* qinb = WSP(bf16, WS_QIN) + (size_t)blkb * 8192;
          float ksf0[8], ksf1[8], ksb0[8], ksb1[8];
#pragma unroll
          for (int rr = 0; rr < 8; ++rr) { const int row = 8 * ig + rr;
              const unsigned qw = *(const GAS unsigned*)(proj + (t0 + row) * NP + Q_OFF + h * 128 + 2 * jp), kw = *(const GAS unsigned*)(proj + (t0 + row) * NP + K_OFF + h * 128 + 2 * jp);
              const float q0 = bflo(qw) * 0.08838834764831845f, q1 = bfhi(qw) * 0.08838834764831845f, k0 = bflo(kw), k1 = bfhi(kw);
              const float f0 = cf[rr][0] + offf0, f1 = cf[rr][1] + offf1, g0 = cb[rr][0] + offb0, g1 = cb[rr][1] + offb1;
              const unsigned qf = pkc(q0 * __expf(f0), q1 * __expf(f1)), kf = pkc(k0 * __expf(-f0), k1 * __expf(-f1));
              const unsigned qb = pkc(q0 * __expf(g0), q1 * __expf(g1)), kb = pkc(k0 * __expf(-g0), k1 * __expf(-g1));
              *(LAS unsigned*)(L + G1_QF + row * G1_P + 4 * jp) = qf; *(LAS unsigned*)(L + G1_KF + row * G1_P + 4 * jp) = kf;
              *(LAS unsigned*)(L + G1_QB + row * G1_P + 4 * jp) = qb; *(LAS unsigned*)(L + G1_KB + row * G1_P + 4 * jp) = kb;
              *(GAS unsigned*)(qinf + row * 128 + 2 * jp) = qf; *(GAS unsigned*)(qinb + row * 128 + 2 * jp) = qb;
              ksf0[rr] = k0 * __expf(blf0 - f0); ksf1[rr] = k1 * __expf(blf1 - f1); ksb0[rr] = k0 * __expf(bb00 - g0); ksb1[rr] = k1 * __expf(bb01 - g1); }
          bf16* kstf = WSP(bf16, WS_KST) + (size_t)blkf * 8192 + (2 * jp) * 64 + 8 * ig; bf16* kstb = WSP(bf16, WS_KST) + (size_t)blkb * 8192 + (2 * jp) * 64 + 8 * ig;
          *(GAS v4u*)kstf = (v4u){pkc(ksf0[0], ksf0[1]), pkc(ksf0[2], ksf0[3]), pkc(ksf0[4], ksf0[5]), pkc(ksf0[6], ksf0[7])};
          *(GAS v4u*)(kstf + 64) = (v4u){pkc(ksf1[0], ksf1[1]), pkc(ksf1[2], ksf1[3]), pkc(ksf1[4], ksf1[5]), pkc(ksf1[6], ksf1[7])};
          *(GAS v4u*)kstb = (v4u){pkc(ksb0[0], ksb0[1]), pkc(ksb0[2], ksb0[3]), pkc(ksb0[4], ksb0[5]), pkc(ksb0[6], ksb0[7])};
          *(GAS v4u*)(kstb + 64) = (v4u){pkc(ksb1[0], ksb1[1]), pkc(ksb1[2], ksb1[3]), pkc(ksb1[4], ksb1[5]), pkc(ksb1[6], ksb1[7])};
          if (ig == 0) { float* dd = WSP(float, WS_DD); *(GAS f32x2v*)(dd + (size_t)blkf * 128 + 2 * jp) = (f32x2v){__expf(blf0), __expf(blf1)}; *(GAS f32x2v*)(dd + (size_t)blkb * 128 + 2 * jp) = (f32x2v){__expf(bb00), __expf(bb01)}; } }
        __syncthreads();
        if (wave < 4) { const int jt = (wave == 1 || wave == 3) ? 1 : 0, it = (wave == 1 || wave == 2) ? 1 : 0; const bool dof = (wave != 3), dob = (wave != 2);
            f32x16 xf, xb;
#pragma unroll
            for (int r = 0; r < 16; ++r) { xf[r] = 0.f; xb[r] = 0.f; }
            const int ao = (32 * jt + l31) * G1_P + 16 * hh, bo = (32 * it + l31) * G1_P + 16 * hh;
            if (dof) {
#pragma unroll
                for (int ks = 0; ks < 8; ++ks) xf = MFMA32(*(const LAS bf16x8*)(L + G1_KF + ao + 32 * ks), *(const LAS bf16x8*)(L + G1_QF + bo + 32 * ks), xf); }
            if (dob) {
#pragma unroll
                for (int ks = 0; ks < 8; ++ks) xb = MFMA32(*(const LAS bf16x8*)(L + G1_KB + ao + 32 * ks), *(const LAS bf16x8*)(L + G1_QB + bo + 32 * ks), xb); }
            const int i = 32 * it + l31;
#pragma unroll
            for (int g = 0; g < 4; ++g) { float vv[4];
#pragma unroll
                for (int e = 0; e < 4; ++e) { const int jq = 32 * jt + 8 * g + 4 * hh + e; vv[e] = ((dof && jq <= i) ? xf[4 * g + e] : 0.f) + ((dob && jq >= i) ? xb[4 * g + e] : 0.f); }
                *(LAS v2u*)(L + G1_ATT + i * G1_VP + (32 * jt + 8 * g + 4 * hh) * 2) = (v2u){pkc(vv[0], vv[1]), pkc(vv[2], vv[3])}; } }
        __syncthreads();
        { bf16* oi = WSP(bf16, WS_OI);
#pragma unroll
          for (int it = 0; it < 2; ++it) { f32x16 acc;
#pragma unroll
              for (int r = 0; r < 16; ++r) acc[r] = 0.f;
#pragma unroll
              for (int ks = 0; ks < 4; ++ks) acc = MFMA32(*(const LAS bf16x8*)(L + G1_ATT + (32 * it + l31) * G1_VP + 32 * ks + 16 * hh), *(const LAS bf16x8*)(L + G1_VT + (32 * wave + l31) * G1_VP + 32 * ks + 16 * hh), acc);
#pragma unroll
              for (int r = 0; r < 16; ++r) { const int i = 32 * it + (r & 3) + 8 * (r >> 2) + 4 * hh; oi[(t0 + i) * 1024 + h * 256 + 32 * wave + l31] = (bf16)f2bf(acc[r]); } } }
    }
    __syncthreads();
}
constexpr int G2_QIN = 0, G2_KST = 17408, G2_VT = 35840, G2_D = 54272, G2_BUF = 54784;
__device__ __forceinline__ void gla_g2(Frame& F, int wg) {
    const int half = wg & 1, bhd = wg >> 1, dir = bhd & 1, bh = bhd >> 1, h = bh & 3, b = bh >> 2;
    LAS unsigned char* L = F.lds;
    const int tid = F.tid, lane = F.lane, wave = F.wave, l31 = lane & 31, hh = lane >> 5;
    const bf16* qin = WSP(bf16, WS_QIN) + (size_t)(bhd * 64) * 8192; const bf16* kst = WSP(bf16, WS_KST) + (size_t)(bhd * 64) * 8192;
    const bf16* vt = WSP(bf16, WS_VT) + (size_t)(bh * 64) * 16384 + half * 8192; const float* dd = WSP(float, WS_DD) + (size_t)(bhd * 64) * 128;
    bf16* og = dir ? WSP(bf16, WS_OB) : WSP(bf16, WS_OF);
    v4u st[6]; v4u std_;
    const int p0 = tid, p1 = tid + 512;
    const int lq0 = G2_QIN + (p0 >> 4) * 272 + (p0 & 15) * 16, lq1 = G2_QIN + (p1 >> 4) * 272 + (p1 & 15) * 16;
    const int lk0 = (p0 >> 3) * 144 + (p0 & 7) * 16, lk1 = (p1 >> 3) * 144 + (p1 & 7) * 16;
#define G2_LOAD(c) do { const GAS v4u* q4 = (const GAS v4u*)(qin + (size_t)(c) * 8192); const GAS v4u* k4 = (const GAS v4u*)(kst + (size_t)(c) * 8192); const GAS v4u* v4 = (const GAS v4u*)(vt + (size_t)(c) * 16384); \
        st[0] = q4[p0]; st[1] = q4[p1]; st[2] = k4[p0]; st[3] = k4[p1]; st[4] = v4[p0]; st[5] = v4[p1]; if (tid < 32) std_ = ((const GAS v4u*)(dd + (size_t)(c) * 128))[tid]; } while (0)
#define G2_STORE(bufo) do { LAS unsigned char* B_ = L + (bufo); *(LAS v4u*)(B_ + lq0) = st[0]; *(LAS v4u*)(B_ + lq1) = st[1]; *(LAS v4u*)(B_ + G2_KST + lk0) = st[2]; *(LAS v4u*)(B_ + G2_KST + lk1) = st[3]; \
        *(LAS v4u*)(B_ + G2_VT + lk0) = st[4]; *(LAS v4u*)(B_ + G2_VT + lk1) = st[5]; if (tid < 32) *(LAS v4u*)(B_ + G2_D + 16 * tid) = std_; } while (0)
    f32x16 S0, S1, S2, S3;
#pragma unroll
    for (int r = 0; r < 16; ++r) { S0[r] = 0.f; S1[r] = 0.f; S2[r] = 0.f; S3[r] = 0.f; }
    bf16x8 Sb[4][2];
#pragma unroll
    for (int t = 0; t < 4; ++t)
#pragma unroll
        for (int s2 = 0; s2 < 2; ++s2) Sb[t][s2] = (bf16x8){0, 0, 0, 0, 0, 0, 0, 0};
    __syncthreads();
    { const int c0 = dir ? 63 : 0; G2_LOAD(c0); G2_STORE(0); }
    __syncthreads();
    for (int nn = 0; nn < 64; ++nn) {
        const int c = dir ? 63 - nn : nn; const int bufo = (nn & 1) * G2_BUF;
        if (nn + 1 < 64) { const int cn = dir ? 62 - nn : nn + 1; G2_LOAD(cn); }
        if (wave < 4) {
            const LAS unsigned char* B = L + bufo;
#pragma unroll
            for (int it = 0; it < 2; ++it) { f32x16 oacc;
#pragma unroll
                for (int r = 0; r < 16; ++r) oacc[r] = 0.f;
#pragma unroll
                for (int t = 0; t < 4; ++t)
#pragma unroll
                    for (int s2 = 0; s2 < 2; ++s2) { const LAS unsigned char* ap = B + G2_QIN + (32 * it + l31) * 272 + (32 * t + 16 * s2 + 4 * hh) * 2;
                        const v2u a_lo = *(const LAS v2u*)ap, a_hi = *(const LAS v2u*)(ap + 16);
                        const bf16x8 af = __builtin_bit_cast(bf16x8, (v4u){a_lo.x, a_lo.y, a_hi.x, a_hi.y});
                        oacc = MFMA32(af, Sb[t][s2], oacc); }
                const size_t tb = (size_t)b * SEQ + c * 64;
#pragma unroll
                for (int r = 0; r < 16; ++r) { const int i = 32 * it + (r & 3) + 8 * (r >> 2) + 4 * hh; og[(tb + i) * 1024 + h * 256 + half * 128 + 32 * wave + l31] = (bf16)f2bf(oacc[r]); } }
#define G2_UPD(SX, t) do { _Pragma("unroll") for (int g = 0; g < 4; ++g) { const f32x4 d4 = *(const LAS f32x4*)(B + G2_D + (32 * (t) + 8 * g + 4 * hh) * 4); \
                SX[4 * g] *= d4[0]; SX[4 * g + 1] *= d4[1]; SX[4 * g + 2] *= d4[2]; SX[4 * g + 3] *= d4[3]; } \
            _Pragma("unroll") for (int ks = 0; ks < 4; ++ks) SX = MFMA32(*(const LAS bf16x8*)(B + G2_KST + (32 * (t) + l31) * 144 + 32 * ks + 16 * hh), *(const LAS bf16x8*)(B + G2_VT + (32 * wave + l31) * 144 + 32 * ks + 16 * hh), SX); \
            _Pragma("unroll") for (int s2 = 0; s2 < 2; ++s2) Sb[t][s2] = __builtin_bit_cast(bf16x8, (v4u){pkc(SX[8 * s2], SX[8 * s2 + 1]), pkc(SX[8 * s2 + 2], SX[8 * s2 + 3]), pkc(SX[8 * s2 + 4], SX[8 * s2 + 5]), pkc(SX[8 * s2 + 6], SX[8 * s2 + 7])}); } while (0)
            G2_UPD(S0, 0); G2_UPD(S1, 1); G2_UPD(S2, 2); G2_UPD(S3, 3);
#undef G2_UPD
        }
        if (nn + 1 < 64) G2_STORE(((nn + 1) & 1) * G2_BUF);
        __syncthreads();
    }
#undef G2_LOAD
#undef G2_STORE
}

__device__ __forceinline__ void gla_finalize(Frame& F) {
    const int gw = F.vcu * NWAVES + F.wave, NGW = F.G * NWAVES;
    const bf16* oi = WSP(bf16, WS_OI); const bf16* of = WSP(bf16, WS_OF); const bf16* ob = WSP(bf16, WS_OB); const bf16* proj = WSP(bf16, WS_PROJ); bf16* og = WSP(bf16, WS_OG);
    const f32x4 gg = ((const GAS f32x4*)F.in[12])[F.lane];
    for (int t = gw; t < T; t += NGW) {
#pragma unroll
        for (int j = 0; j < 4; ++j) { const size_t o = (size_t)t * 1024 + 256 * j + 4 * F.lane;
            const v2u a = *(const GAS v2u*)(oi + o), bq = *(const GAS v2u*)(of + o), c = *(const GAS v2u*)(ob + o);
            f32x4 v = (f32x4){bflo(a.x) + bflo(bq.x) + bflo(c.x), bfhi(a.x) + bfhi(bq.x) + bfhi(c.x), bflo(a.y) + bflo(bq.y) + bflo(c.y), bfhi(a.y) + bfhi(bq.y) + bfhi(c.y)};
            const float ms = wave_sum((v.x * v.x + v.y * v.y) + (v.z * v.z + v.w * v.w)) * (1.0f / 256.0f); const float rs = 1.0f / sqrtf(ms + RMS_EPS);
            const v2u rw = *(const GAS v2u*)(proj + (size_t)t * NP + R_OFF + 256 * j + 4 * F.lane);
            const float r0 = bflo(rw.x), r1 = bfhi(rw.x), r2 = bflo(rw.y), r3 = bfhi(rw.y);
            v = v * rs * gg;
            v.x *= r0 / (1.0f + __expf(-r0)); v.y *= r1 / (1.0f + __expf(-r1)); v.z *= r2 / (1.0f + __expf(-r2)); v.w *= r3 / (1.0f + __expf(-r3));
            *(GAS v2u*)(og + o) = (v2u){pk2(v.x, v.y), pk2(v.z, v.w)}; }
    }
}

__device__ __forceinline__ void xattn_naive(Frame& F) {
    const int gw = F.vcu * NWAVES + F.wave, NGW = F.G * NWAVES;
    const bf16* proj = WSP(bf16, WS_PROJ); const bf16* kv = WSP(bf16, WS_KV); bf16* om = WSP(bf16, WS_OM);
    LAS float* qs = (LAS float*)(F.lds + F.wave * 8192);
    LAS float* ps = qs + 512;
    for (int task = gw; task < T; task += NGW) {
        const int h = task & 3, t0 = (task >> 2) * 4, b = t0 >> 12;
        { const int tk = F.lane >> 4, d0 = (F.lane & 15) * 8; const v4u w = *(const GAS v4u*)(proj + (size_t)(t0 + tk) * NP + MQ_OFF + h * 128 + d0);
          LAS float* q = qs + tk * 128 + d0; q[0] = bflo(w.x); q[1] = bfhi(w.x); q[2] = bflo(w.y); q[3] = bfhi(w.y); q[4] = bflo(w.z); q[5] = bfhi(w.z); q[6] = bflo(w.w); q[7] = bfhi(w.w); }
        LDS_WAIT(); asm volatile("" ::: "memory");
        float sc[4][4];
#pragma unroll
        for (int i = 0; i < 4; ++i)
#pragma unroll
            for (int tk = 0; tk < 4; ++tk) sc[tk][i] = 0.f;
#pragma unroll
        for (int i = 0; i < 4; ++i) { const bf16* kr = kv + (size_t)(b * 256 + F.lane + 64 * i) * 1024 + h * 128;
#pragma unroll 2
            for (int c = 0; c < 16; ++c) { const v4u w = *(const GAS v4u*)(kr + 8 * c); const float kf[8] = {bflo(w.x), bfhi(w.x), bflo(w.y), bfhi(w.y), bflo(w.z), bfhi(w.z), bflo(w.w), bfhi(w.w)};
#pragma unroll
                for (int tk = 0; tk < 4; ++tk) { const f32x4 qa = *(const LAS f32x4*)(qs + tk * 128 + 8 * c), qb = *(const LAS f32x4*)(qs + tk * 128 + 8 * c + 4);
                    sc[tk][i] += (qa[0] * kf[0] + qa[1] * kf[1]) + (qa[2] * kf[2] + qa[3] * kf[3]) + (qb[0] * kf[4] + qb[1] * kf[5]) + (qb[2] * kf[6] + qb[3] * kf[7]); } } }
#pragma unroll
        for (int tk = 0; tk < 4; ++tk) { float mx = -3.0e38f;
#pragma unroll
            for (int i = 0; i < 4; ++i) { sc[tk][i] *= 0.08838834764831845f; mx = fmaxf(mx, sc[tk][i]); }
            mx = wave_max(mx); float sm = 0.f;
#pragma unroll
            for (int i = 0; i < 4; ++i) { sc[tk][i] = __expf(sc[tk][i] - mx); sm += sc[tk][i]; }
            sm = 1.0f / wave_sum(sm);
#pragma unroll
            for (int i = 0; i < 4; ++i) ps[tk * 256 + F.lane + 64 * i] = sc[tk][i] * sm; }
        LDS_WAIT(); asm volatile("" ::: "memory");
        float o[4][2];
#pragma unroll
        for (int tk = 0; tk < 4; ++tk) { o[tk][0] = 0.f; o[tk][1] = 0.f; }
        const bf16* vr = kv + (size_t)(b * 256) * 1024 + 512 + h * 128 + 2 * F.lane;
#pragma unroll 2
        for (int k4 = 0; k4 < 64; ++k4) { float v0[4], v1[4];
#pragma unroll
            for (int j = 0; j < 4; ++j) { const unsigned w = *(const GAS unsigned*)(vr + (size_t)(4 * k4 + j) * 1024); v0[j] = bflo(w); v1[j] = bfhi(w); }
#pragma unroll
            for (int tk = 0; tk < 4; ++tk) { const f32x4 p = *(const LAS f32x4*)(ps + tk * 256 + 4 * k4);
#pragma unroll
                for (int j = 0; j < 4; ++j) { o[tk][0] += p[j] * v0[j]; o[tk][1] += p[j] * v1[j]; } } }
#pragma unroll
        for (int tk = 0; tk < 4; ++tk) *(GAS unsigned*)(om + (size_t)(t0 + tk) * 512 + h * 128 + 2 * F.lane) = pk2(o[tk][0], o[tk][1]);
        LDS_WAIT(); asm volatile("" ::: "memory");
    }
}

__device__ __forceinline__ void router_phase(Frame& F) {
    LAS int* hist = (LAS int*)(F.lds);
    const bf16* h1b = WSP(bf16, WS_HB); const bf16* wrt = WSP(bf16, WS_WRT); const float* brt = F.in[22];
    int* list = WSP(int, WS_RT); float* topw = WSP(float, WS_TOPW); unsigned* cnt = (unsigned*)(F.ws + WS_CTL) + CW_CNT;
    const int tq = F.lane & 15, q = F.lane >> 4;
    for (int it = F.vcu; it < T / 128; it += F.G) {
        if (F.tid < 64) hist[F.tid] = 0;
        __syncthreads();
        const int tok = it * 128 + F.wave * 16 + tq;
        f32x4 a0 = {0.f, 0.f, 0.f, 0.f}, a1 = {0.f, 0.f, 0.f, 0.f};
        const bf16* ap0 = wrt + (size_t)tq * 1024 + 8 * q; const bf16* ap1 = wrt + (size_t)(16 + tq) * 1024 + 8 * q; const bf16* bp = h1b + (size_t)tok * 1024 + 8 * q;
#pragma unroll 4
        for (int ks = 0; ks < 32; ++ks) { const bf16x8 bf = *(const GAS bf16x8*)(bp + 32 * ks);
            a0 = __builtin_amdgcn_mfma_f32_16x16x32_bf16(*(const GAS bf16x8*)(ap0 + 32 * ks), bf, a0, 0, 0, 0);
            a1 = __builtin_amdgcn_mfma_f32_16x16x32_bf16(*(const GAS bf16x8*)(ap1 + 32 * ks), bf, a1, 0, 0, 0); }
        float lv[8]; int taken = 0;
#pragma unroll
        for (int r = 0; r < 4; ++r) { lv[r] = a0[r] + brt[4 * q + r]; lv[4 + r] = a1[r] + brt[16 + 4 * q + r]; }
        float tv[4]; int te[4];
#pragma unroll
        for (int k = 0; k < 4; ++k) { float bv = -3.0e38f; int be = 64;
#pragma unroll
            for (int r = 0; r < 8; ++r) { const int e = (r < 4) ? 4 * q + r : 16 + 4 * q + (r - 4); const bool ok = !((taken >> r) & 1) && (lv[r] > bv || (lv[r] == bv && e < be)); bv = ok ? lv[r] : bv; be = ok ? e : be; }
#pragma unroll
            for (int o = 16; o < 64; o <<= 1) { const float ov = __shfl_xor(bv, o); const int oe = __shfl_xor(be, o); const bool tk = (ov > bv) || (ov == bv && oe < be); bv = tk ? ov : bv; be = tk ? oe : be; }
            tv[k] = bv; te[k] = be;
#pragma unroll
            for (int r = 0; r < 8; ++r) { const int e = (r < 4) ? 4 * q + r : 16 + 4 * q + (r - 4); if (e == be) taken |= (1 << r); } }
        const float e1 = __expf(tv[1] - tv[0]), e2 = __expf(tv[2] - tv[0]), e3 = __expf(tv[3] - tv[0]); const float inv = 1.0f / (1.0f + e1 + e2 + e3);
        const float wk = (q == 0 ? 1.0f : q == 1 ? e1 : q == 2 ? e2 : e3) * inv; const int ek = (q == 0 ? te[0] : q == 1 ? te[1] : q == 2 ? te[2] : te[3]);
        const int a = tok * 4 + q;
        const int lpos = __hip_atomic_fetch_add(&hist[ek], 1, __ATOMIC_RELAXED, __HIP_MEMORY_SCOPE_WORKGROUP);
        __syncthreads();
        if (F.tid < 32) hist[32 + F.tid] = (int)__hip_atomic_fetch_add(cnt + F.tid, (unsigned)hist[F.tid], RLX_AGENT);
        __syncthreads();
        list[ek * T + hist[32 + ek] + lpos] = a; topw[a] = wk;
        __syncthreads();
    }
}

__device__ __forceinline__ void final_phase(Frame& F) {
    const int gw = F.vcu * NWAVES + F.wave, NGW = F.G * NWAVES;
    const float* h1 = WSP(float, WS_H); const bf16* yb = WSP(bf16, WS_YB);
    for (int t = gw; t < T; t += NGW) {
        f32x4 v[4]; float s = 0.f;
#pragma unroll
        for (int j = 0; j < 4; ++j) { v[j] = ((const GAS f32x4*)(h1 + (size_t)t * 1024))[F.lane + 64 * j] * DN_ALPHA;
#pragma unroll
            for (int k = 0; k < 4; ++k) { const v2u w = *(const GAS v2u*)(yb + ((size_t)t * 4 + k) * 1024 + 256 * j + 4 * F.lane); v[j] += (f32x4){bflo(w.x), bfhi(w.x), bflo(w.y), bfhi(w.y)}; }
            s += (v[j].x + v[j].y) + (v[j].z + v[j].w); }
        const float mean = wave_sum(s) * (1.f / D); float s2 = 0.f;
#pragma unroll
        for (int j = 0; j < 4; ++j) { v[j] = v[j] - mean; s2 += (v[j].x * v[j].x + v[j].y * v[j].y) + (v[j].z * v[j].z + v[j].w * v[j].w); }
        const float rstd = 1.f / sqrtf(wave_sum(s2) * (1.f / D) + LN_EPS);
#pragma unroll
        for (int j = 0; j < 4; ++j) { const f32x4 gg = ((const GAS f32x4*)F.in[27])[F.lane + 64 * j], bb = ((const GAS f32x4*)F.in[28])[F.lane + 64 * j];
            ((GAS f32x4*)(F.out + (size_t)t * 1024))[F.lane + 64 * j] = v[j] * rstd * gg + bb; }
    }
}

struct Args { const float* in[29]; float* out; unsigned char* ws; int ph_lo, ph_hi, li, pad; };
__global__ void __launch_bounds__(NWAVES * 64, 2) mega_fwd(Args args) {
    extern __shared__ __attribute__((aligned(16))) unsigned char lds[];
    Frame F;
    F.lds = (LAS unsigned char*)lds;
    F.tid = threadIdx.x; F.lane = F.tid & 63; F.wave = __builtin_amdgcn_readfirstlane(F.tid >> 6);
    F.G = gridDim.x; { const int bx = blockIdx.x; F.vcu = (F.G % 8 == 0) ? (bx % 8) * (F.G / 8) + bx / 8 : bx; }
#pragma unroll
    for (int i = 0; i < 29; ++i) F.in[i] = args.in[i];
    F.out = args.out; F.ws = args.ws;
    volatile LAS unsigned* MISC = (volatile LAS unsigned*)(F.lds + MISC_OFF);
    for (int u = F.tid; u < (LDS_BYTES - LDSCTL_OFF) / 4; u += NWAVES * 64) ((LAS unsigned*)(F.lds + LDSCTL_OFF))[u] = 0u;
    __syncthreads();
    unsigned* ctl = (unsigned*)(F.ws + WS_CTL);
    XcdBarrier bar; bar.bar = ctl + CW_BAR; bar.x = 0; bar.st = nullptr;
#if !MK_PER_PHASE
    bar = xcd_barrier_post(ctl + CW_BAR, MISC + 8);
#define GRID_BAR() xcd_barrier(bar)
#else
#define GRID_BAR() do {} while (0)
#endif
    const int lo = args.ph_lo, hi = args.ph_hi;
#ifndef PH_MASK
#define PH_MASK 0xfff
#endif
#define IN(k) (((PH_MASK >> (k)) & 1) && lo <= (k) && (k) < hi)
#define BOTH(k) (IN(k) && IN((k) + 1))
    const int bx = (int)blockIdx.x;

    if (IN(0)) { p0_prologue(F); if (BOTH(0)) GRID_BAR(); }

    if (IN(1)) {
        { pg8::Gemm g{WSP(bf16, WS_HB), WSP(bf16, WS_WIN), D, D, D}; pg8::StaticOrder S; S.init(T, NP, F.G, bx, D, D);
          EpiBias E{WSP(bf16, WS_PROJ), NP, WSP(float, WS_BIN)}; pg8::gemm_phase(F.lds, g, S, E); }
        { pg8::Gemm g{WSP(bf16, WS_WZ), WSP(bf16, WS_HB), D, D, D}; pg8::StaticOrder S; S.init(1024, T, F.G, bx, D, D);
          EpiZT E{WSP(bf16, WS_ZT), WSP(float, WS_BZ)}; pg8::gemm_phase(F.lds, g, S, E); }
        { pg8::Gemm g{WSP(bf16, WS_MEMN), WSP(bf16, WS_WKV), D, D, D}; pg8::StaticOrder S; S.init(NB * MEM, 1024, F.G, F.G - 1 - bx, D, D);
          EpiBias E{WSP(bf16, WS_KV), 1024, nullptr}; pg8::gemm_phase(F.lds, g, S, E); }
        if (BOTH(1)) GRID_BAR();
    }

    if (IN(2)) {
        gla_g1(F);
#ifndef NO_XATTN
        xattn_naive(F);
#endif
        if (BOTH(2)) GRID_BAR();
    }

    if (IN(3)) {
        if (bx < 64) gla_g2(F, bx);
        __syncthreads();
        { pg8::Gemm g{WSP(bf16, WS_DFT), WSP(bf16, WS_ZT), 8192, 8192, 8192}; pg8::StaticOrder S; S.init(SEQ, 512, F.G, F.G - 1 - bx, 8192, 8192, NB, 0, (size_t)512 * 8192 * 2);
          EpiFnet E{WSP(bf16, WS_F)}; pg8::gemm_phase(F.lds, g, S, E); }
        if (BOTH(3)) GRID_BAR();
    }

    if (IN(4)) { gla_finalize(F); if (BOTH(4)) GRID_BAR(); }

    if (IN(5)) {
        const bf16* gate = WSP(bf16, WS_PROJ) + G_OFF;
        { pg8::Gemm g{WSP(bf16, WS_OG), WSP(bf16, WS_WGLA), 1024, 1024, 1024}; pg8::StaticOrder S; S.init(T, D, F.G, bx, 1024, 1024);
          EpiGate<0> E{WSP(float, WS_MG), WSP(bf16, WS_MGB), gate}; pg8::gemm_phase(F.lds, g, S, E); }
        { pg8::Gemm g{WSP(bf16, WS_F), WSP(bf16, WS_WFN), 512, 512, 512}; pg8::StaticOrder S; S.init(T, D, F.G, bx, 512, 512);
          EpiGate<1> E{WSP(float, WS_MG), WSP(bf16, WS_MGB), gate + 1024}; pg8::gemm_phase(F.lds, g, S, E); }
        { pg8::Gemm g{WSP(bf16, WS_OM), WSP(bf16, WS_WMEM), 512, 512, 512}; pg8::StaticOrder S; S.init(T, D, F.G, bx, 512, 512);
          EpiGate<2> E{WSP(float, WS_MG), WSP(bf16, WS_MGB), gate + 2048}; pg8::gemm_phase(F.lds, g, S, E); }
        if (BOTH(5)) GRID_BAR();
    }

    if (IN(6)) {
        pg8::Gemm g{WSP(bf16, WS_MGB), WSP(bf16, WS_WOUT), 1024, 1024, 1024}; pg8::StaticOrder S; S.init(T, D, F.G, bx, 1024, 1024);
        EpiOut E{WSP(float, WS_H), F.in[18]}; pg8::gemm_phase(F.lds, g, S, E);
        if (BOTH(6)) GRID_BAR();
    }

    if (IN(7)) {
        const int gw = F.vcu * NWAVES + F.wave, NGW = F.G * NWAVES;
        for (int m = gw; m < T; m += NGW) ln_row(WSP(float, WS_H) + (size_t)m * D, F.in[19], F.in[20], WSP(float, WS_H) + (size_t)m * D, WSP(bf16, WS_HB) + (size_t)m * D, F.lane, 1.0f);
        if (BOTH(7)) GRID_BAR();
    }

    if (IN(8)) { router_phase(F); if (BOTH(8)) GRID_BAR(); }

    if (IN(9) || IN(10)) {
        volatile LAS int* tb = (volatile LAS int*)(F.lds + MISC_OFF + 256);
        __syncthreads();
        if (F.tid == 0) { const unsigned* cnt = ctl + CW_CNT; int acc = 0;
            for (int e = 0; e < 32; ++e) { const int c = (int)__hip_atomic_load(cnt + e, RLX_AGENT); tb[e] = c; tb[32 + e] = acc; acc += (c + 255) >> 8; }
            tb[64] = acc; }
        __syncthreads();
        if (IN(9)) {
            MoeSched<8, true> S; S.tb = tb; S.list = WSP(int, WS_RT); S.G = F.G; S.c = bx; S.lda = 1024; S.ldb = 1024; S.bstride = (size_t)2048 * 1024 * 2;
            pg8::Gemm g{WSP(bf16, WS_HB), WSP(bf16, WS_WGU), 1024, 1024, 1024};
            EpiSwiglu E{WSP(bf16, WS_ACT), WSP(float, WS_BGU), S}; pg8::gemm_phase(F.lds, g, S, E);
            if (BOTH(9)) GRID_BAR();
        }
        if (IN(10)) {
            MoeSched<4, false> S; S.tb = tb; S.list = WSP(int, WS_RT); S.G = F.G; S.c = bx; S.lda = 1024; S.ldb = 1024; S.bstride = (size_t)1024 * 1024 * 2;
            pg8::Gemm g{WSP(bf16, WS_ACT), WSP(bf16, WS_WDN), 1024, 1024, 1024};
            EpiDown E{WSP(bf16, WS_YB), F.in[26], WSP(float, WS_TOPW), WSP(int, WS_RT), S}; pg8::gemm_phase(F.lds, g, S, E);
            if (BOTH(10)) GRID_BAR();
        }
    }

    if (IN(11)) final_phase(F);
#undef IN
#undef BOTH
}

extern "C" void kernel_launch(void* const* d_in, const int* in_sizes, int n_in, void* d_out, int out_size, void* d_ws, size_t ws_size, hipStream_t stream) {
    static int grid = 0;
    if (grid == 0) {
        if (n_in != 29 || out_size != T * D || ws_size < WS_END) { fprintf(stderr, "kernel_launch: unexpected shapes (n_in %d out %d ws %zu need %zu)\n", n_in, out_size, ws_size, (size_t)WS_END); grid = -1; return; }
        int dev = 0, cus = 0, per_cu = 0;
        if (hipGetDevice(&dev) != hipSuccess || hipDeviceGetAttribute(&cus, hipDeviceAttributeMultiprocessorCount, dev) != hipSuccess) { grid = -1; return; }
        if (hipFuncSetAttribute((const void*)mega_fwd, hipFuncAttributeMaxDynamicSharedMemorySize, LDS_BYTES) != hipSuccess) { fprintf(stderr, "kernel_launch: hipFuncSetAttribute failed\n"); grid = -1; return; }
        if (hipOccupancyMaxActiveBlocksPerMultiprocessor(&per_cu, (const void*)mega_fwd, NWAVES * 64, LDS_BYTES) != hipSuccess || per_cu < 1) fprintf(stderr, "kernel_launch: occupancy query says %d\n", per_cu);
        (void)hipGetLastError();
        grid = cus;
    }
    if (grid < 0) return;
    (void)in_sizes;
    if (hipMemsetAsync((char*)d_ws + WS_CTL, 0, CTL_ZERO_BYTES, stream) != hipSuccess) return;
    Args a{};
    for (int i = 0; i < 29; ++i) a.in[i] = (const float*)d_in[i];
    a.out = (float*)d_out; a.ws = (unsigned char*)d_ws;
#if MK_PER_PHASE
    for (int p = 0; p < N_PHASES; ++p) { a.ph_lo = p; a.ph_hi = p + 1; a.li = p; hipLaunchKernelGGL(mega_fwd, dim3(grid), dim3(NWAVES * 64), LDS_BYTES, stream, a); }
#else
    a.ph_lo = 0; a.ph_hi = N_PHASES; a.li = 0;
    hipLaunchKernelGGL(mega_fwd, dim3(grid), dim3(NWAVES * 64), LDS_BYTES, stream, a);
#endif
}
```

```cpp
#include <hip/hip_runtime.h>
#include <cstdio>
#include <cstdint>

#ifndef MK_PER_PHASE
#define MK_PER_PHASE 0
#endif

namespace pg8 {
#define PG8_LAS __attribute__((address_space(3)))
typedef unsigned short bf16_t;
typedef short bf16x8 __attribute__((ext_vector_type(8)));
typedef float f32x4 __attribute__((ext_vector_type(4)));
typedef float f32x2 __attribute__((ext_vector_type(2)));
typedef unsigned u32x4 __attribute__((ext_vector_type(4)));
typedef unsigned u32x2 __attribute__((ext_vector_type(2)));
constexpr int BM = 256, BK = 64, HALF = 128, HTB = HALF * BK * 2, STAGE_BYTES = 8 * HTB, NXCD = 8, WGM = 8;

__host__ __device__ __forceinline__ int lds_byte(int r, int c) { const int st = (r >> 4) * 2 + (c >> 5), rr = r & 15, cc = c & 31, ob = rr * 64 + cc * 2; return st * 1024 + (ob ^ (((ob >> 9) & 1) << 5)); }
__host__ __device__ __forceinline__ void stage_rc(int b, int& R, int& C) { const int st = b / 1024, sb = b % 1024, swz = sb ^ (((sb >> 9) & 1) << 5); R = (st >> 1) * 16 + swz / 64; C = (st & 1) * 32 + (swz % 64) / 2; }
__host__ __device__ __forceinline__ int perm32(int rho) { const int n = rho >> 4, i = rho & 15; return 8 * (i >> 2) + 4 * n + (i & 3); }

struct Unit { int pm, pn, z; };
struct Gemm { const bf16_t* A; const bf16_t* Bt; int lda, ldb, K; };

struct StaticOrder {
    static constexpr bool GATHER = false;
    int nM, nN, nwg, G, c, nz; size_t az, bz;
    int lda, ldb;
    __device__ void init(int M, int N, int G_, int c_, int lda_, int ldb_, int nz_ = 1, size_t az_ = 0, size_t bz_ = 0) { nM = M / BM; nN = N / BM; nwg = nM * nN; G = G_; c = c_; nz = nz_; az = az_; bz = bz_; lda = lda_; ldb = ldb_; }
    __device__ bool next(int i, Unit& u) const {
        const long L = (long)i * G + c; if (c < 0 || L >= (long)nwg * nz) return false;
        int wgid = (int)(L % nwg); u.z = (int)(L / nwg);
        { const int q = nwg / NXCD, r = nwg % NXCD, xcd = wgid % NXCD, off = wgid / NXCD; wgid = (xcd < r ? xcd * (q + 1) : r * (q + 1) + (xcd - r) * q) + off; }
        const int nig = WGM * nN, gid = wgid / nig, fm = gid * WGM, gsz = (nM - fm) < WGM ? (nM - fm) : WGM;
        u.pm = fm + ((wgid % nig) % gsz); u.pn = (wgid % nig) / gsz; return true;
    }
    __device__ __forceinline__ size_t a_off(const Unit& u) const { return (size_t)u.z * az + (size_t)u.pm * BM * lda * 2; }
    __device__ __forceinline__ size_t b_off(const Unit& u) const { return (size_t)u.z * bz + (size_t)u.pn * BM * ldb * 2; }
    __device__ __forceinline__ unsigned gather_row(const Unit&, int) const { return 0u; }
};

__device__ __forceinline__ unsigned cvt_pk_bf16(float lo, float hi) { unsigned r; asm volatile("v_cvt_pk_bf16_f32 %0, %1, %2" : "=v"(r) : "v"(lo), "v"(hi)); return r; }

template <class Epi, class Sched>
__device__ __forceinline__ void gemm_phase(PG8_LAS unsigned char* lds, const Gemm g, const Sched& S, const Epi& E) {
    constexpr bool GA = Sched::GATHER;
    const int tid = threadIdx.x, wid = __builtin_amdgcn_readfirstlane(tid >> 6), lane = tid & 63, wr = wid >> 2, wc = wid & 3, fr = lane & 15, fq = lane >> 4;
    const int K = g.K, nt = K / BK;
    unsigned voffA[2], voffB[2]; int RA[2], CA[2];
#pragma unroll
    for (int i = 0; i < 2; ++i) { int R, C; stage_rc(tid * 16 + i * 8192, R, C); const int Rb = Epi::PERM ? ((R & ~31) + perm32(R & 31)) : R;
        RA[i] = R; CA[i] = C; voffA[i] = (unsigned)(R * g.lda + C) * 2u; voffB[i] = (unsigned)(Rb * g.ldb + C) * 2u; }
    const size_t kstep = (size_t)(BK * 2);
    const size_t hstepA = GA ? 0 : (size_t)HALF * g.lda * 2, hstepB = (size_t)HALF * g.ldb * 2;
    const unsigned ldsw = (unsigned)wid * 1024u;
    const int aoff = lds_byte(wr * 64 + fr, fq * 8), boff = lds_byte(wc * 32 + fr, fq * 8);
    unsigned vgc[2][2], vgn[2][2];
#define PG8_SA(b, h) (((b) * 2 + (h)) * HTB)
#define PG8_SB(b, h) ((4 + (b) * 2 + (h)) * HTB)
#define PG8_STAGE(bufoff, gbase, voff) do { _Pragma("unroll") for (int _i = 0; _i < 2; ++_i) \
        __builtin_amdgcn_global_load_lds((const unsigned*)((const char*)(gbase) + (voff)[_i]), (PG8_LAS unsigned*)(lds + (bufoff) + ldsw + _i * 8192), 16, 0, 0); } while (0)
#define PG8_STAGE_A(bufoff, gbase, h, nx) do { if constexpr (GA) { unsigned _v[2]; _v[0] = (nx) ? vgn[h][0] : vgc[h][0]; _v[1] = (nx) ? vgn[h][1] : vgc[h][1]; PG8_STAGE(bufoff, gbase, _v); } \
        else { PG8_STAGE(bufoff, (gbase) + (h) * hstepA, voffA); } } while (0)
#define PG8_LDA(dst, b, h) do { _Pragma("unroll") for (int m = 0; m < 4; ++m) _Pragma("unroll") for (int k = 0; k < 2; ++k) dst[m][k] = *(const PG8_LAS bf16x8*)(lds + PG8_SA(b, h) + aoff + m * 2048 + k * 1024); } while (0)
#define PG8_LDB(dst, b, h) do { _Pragma("unroll") for (int n = 0; n < 2; ++n) _Pragma("unroll") for (int k = 0; k < 2; ++k) dst[n][k] = *(const PG8_LAS bf16x8*)(lds + PG8_SB(b, h) + boff + n * 2048 + k * 1024); } while (0)
#define PG8_MMA(ai, bj, At, Bt) do { __builtin_amdgcn_s_setprio(1); _Pragma("unroll") for (int m = 0; m < 4; ++m) _Pragma("unroll") for (int n = 0; n < 2; ++n) _Pragma("unroll") for (int k = 0; k < 2; ++k) \
        acc[ai][bj][m][n] = __builtin_amdgcn_mfma_f32_16x16x32_bf16(Bt[n][k], At[m][k], acc[ai][bj][m][n], 0, 0, 0); __builtin_amdgcn_s_setprio(0); } while (0)
#define PG8_WAIT_V(n) asm volatile("s_waitcnt vmcnt(" #n ")" ::: "memory")
#define PG8_WAIT_L(n) asm volatile("s_waitcnt lgkmcnt(" #n ")" ::: "memory")
#define PG8_BAR __builtin_amdgcn_s_barrier()
#define PG8_SCHED __builtin_amdgcn_sched_barrier(0)
    Unit cur, nxt; int ui = 0;
    if (!S.next(0, cur)) return;
    f32x4 acc[2][2][4][2];
#pragma unroll
    for (int a = 0; a < 2; ++a)
#pragma unroll
        for (int b = 0; b < 2; ++b)
#pragma unroll
            for (int m = 0; m < 4; ++m)
#pragma unroll
                for (int n = 0; n < 2; ++n) acc[a][b][m][n] = (f32x4){0.f, 0.f, 0.f, 0.f};
    bf16x8 At[4][2], B0[2][2], B1[2][2];
    const char* cA = (const char*)g.A + (GA ? 0 : S.a_off(cur)); const char* cB = (const char*)g.Bt + S.b_off(cur);
    if constexpr (GA) {
#pragma unroll
        for (int h = 0; h < 2; ++h)
#pragma unroll
            for (int i = 0; i < 2; ++i) { vgc[h][i] = S.gather_row(cur, h * HALF + RA[i]) + (unsigned)CA[i] * 2u; vgn[h][i] = vgc[h][i]; }
    }
    PG8_STAGE(PG8_SB(0, 0), cB, voffB); PG8_STAGE(PG8_SB(0, 1), cB + hstepB, voffB); PG8_STAGE_A(PG8_SA(0, 0), cA, 0, false); PG8_STAGE_A(PG8_SA(0, 1), cA, 1, false);
    if (wr == 1) PG8_BAR;
    PG8_WAIT_V(2); PG8_BAR;
    PG8_STAGE(PG8_SB(1, 0), cB + kstep, voffB); PG8_STAGE_A(PG8_SA(1, 0), cA + kstep, 0, false); PG8_STAGE(PG8_SB(1, 1), cB + hstepB + kstep, voffB);
    PG8_WAIT_V(6); PG8_BAR;
    for (;;) {
        const bool has_next = S.next(ui + 1, nxt);
        const char* nA = has_next ? (const char*)g.A + (GA ? 0 : S.a_off(nxt)) : cA; const char* nB = has_next ? (const char*)g.Bt + S.b_off(nxt) : cB;
        if constexpr (GA) { if (has_next) {
#pragma unroll
            for (int h = 0; h < 2; ++h)
#pragma unroll
                for (int i = 0; i < 2; ++i) vgn[h][i] = S.gather_row(nxt, h * HALF + RA[i]) + (unsigned)CA[i] * 2u; } }
        for (int t = 0; t < nt; t += 2) {
            const bool last = (t == nt - 2);
            const char* a1 = cA + (size_t)(t + 1) * kstep;
            const char* a2 = last ? nA : cA + (size_t)(t + 2) * kstep; const char* b2 = last ? nB : cB + (size_t)(t + 2) * kstep;
            const char* a3 = a2 + kstep; const char* b3 = b2 + kstep;
            PG8_LDB(B0, 0, 0); PG8_LDB(B1, 0, 1); PG8_SCHED; PG8_LDA(At, 0, 0); PG8_STAGE_A(PG8_SA(1, 1), a1, 1, false);
            PG8_WAIT_V(8); PG8_WAIT_L(0); PG8_BAR; PG8_MMA(0, 0, At, B0); PG8_MMA(0, 1, At, B1); PG8_BAR; PG8_SCHED;
            PG8_LDA(At, 0, 1); PG8_STAGE(PG8_SB(0, 0), b2, voffB); PG8_STAGE(PG8_SB(0, 1), b2 + hstepB, voffB); PG8_STAGE_A(PG8_SA(0, 0), a2, 0, last);
            PG8_WAIT_V(8); PG8_WAIT_L(0); PG8_BAR; PG8_MMA(1, 0, At, B0); PG8_MMA(1, 1, At, B1); PG8_BAR; PG8_SCHED;
            PG8_LDB(B0, 1, 0); PG8_LDB(B1, 1, 1); PG8_SCHED; PG8_LDA(At, 1, 0); PG8_STAGE_A(PG8_SA(0, 1), a2, 1, last);
            PG8_WAIT_V(8); PG8_WAIT_L(0); PG8_BAR; PG8_MMA(0, 0, At, B0); PG8_MMA(0, 1, At, B1); PG8_BAR; PG8_SCHED;
            PG8_LDA(At, 1, 1); PG8_STAGE(PG8_SB(1, 0), b3, voffB); PG8_STAGE(PG8_SB(1, 1), b3 + hstepB, voffB); PG8_STAGE_A(PG8_SA(1, 0), a3, 0, last);
            PG8_WAIT_V(8); PG8_WAIT_L(0); PG8_BAR; PG8_MMA(1, 0, At, B0); PG8_MMA(1, 1, At, B1); PG8_BAR; PG8_SCHED;
        }
        if (wr == 0) PG8_BAR;
        E(acc, cur, wr, wc, fr, fq);
        if (!has_next) break;
#pragma unroll
        for (int a = 0; a < 2; ++a)
#pragma unroll
            for (int b = 0; b < 2; ++b)
#pragma unroll
                for (int m = 0; m < 4; ++m)
#pragma unroll
                    for (int n = 0; n < 2; ++n) acc[a][b][m][n] = (f32x4){0.f, 0.f, 0.f, 0.f};
        cur = nxt; cA = nA; cB = nB; ++ui;
        if constexpr (GA) {
#pragma unroll
            for (int h = 0; h < 2; ++h)
#pragma unroll
                for (int i = 0; i < 2; ++i) vgc[h][i] = vgn[h][i]; }
        if (wr == 1) PG8_BAR;
    }
    PG8_WAIT_V(0);
    PG8_BAR;
#undef PG8_SA
#undef PG8_SB
#undef PG8_STAGE
#undef PG8_STAGE_A
#undef PG8_LDA
#undef PG8_LDB
#undef PG8_MMA
#undef PG8_WAIT_V
#undef PG8_WAIT_L
#undef PG8_BAR
#undef PG8_SCHED
}
}

constexpr int NWAVES = 8;
constexpr int T = 16384, D = 1024, NB = 4, SEQ = 4096, NP = 6912, MEM = 256;
constexpr int Q_OFF = 0, K_OFF = 512, V_OFF = 1024, R_OFF = 2048, MQ_OFF = 3072, G_OFF = 3584, LR_OFF = 6656;
constexpr int IN_W = 7200, LR_SRC = 3072, FN_SRC = 3104, MQ_SRC = 3616, G_SRC = 4128;
constexpr int NE = 32, DFF = 1024, ACT_ROWS = 73728;
constexpr float LN_EPS = 1e-5f, RMS_EPS = 1e-6f;
constexpr float DN_ALPHA = 1.18920711500272f;
constexpr int N_PHASES = 12;

constexpr size_t MiB = 1u << 20;
constexpr size_t WS_CTL = 0, CTL_ZERO_BYTES = 1 * MiB;
constexpr size_t WS_WIN = 1 * MiB;
constexpr size_t WS_WZ = 15 * MiB;
constexpr size_t WS_WKV = 17 * MiB;
constexpr size_t WS_WGLA = 19 * MiB;
constexpr size_t WS_WFN = 21 * MiB;
constexpr size_t WS_WMEM = 22 * MiB;
constexpr size_t WS_WOUT = 23 * MiB;
constexpr size_t WS_WRT = 25 * MiB;
constexpr size_t WS_BIN = WS_WRT + 65536;
constexpr size_t WS_BZ = WS_BIN + 32768;
constexpr size_t WS_BGU = WS_BZ + 4096;
constexpr size_t WS_WGU = 26 * MiB;
constexpr size_t WS_WDN = 154 * MiB;
constexpr size_t WS_H = 218 * MiB;
constexpr size_t WS_HB = 282 * MiB;
constexpr size_t WS_MEMN = 314 * MiB;
constexpr size_t WS_KV = 316 * MiB;
constexpr size_t WS_RT = 318 * MiB;
constexpr size_t WS_TOPW = WS_RT + 2 * MiB;
constexpr size_t WS_PROJ = 321 * MiB;
constexpr size_t WS_ZT = 537 * MiB;
constexpr size_t WS_DFT = 569 * MiB;
constexpr size_t WS_ACT = 321 * MiB;
constexpr size_t WS_YB = 465 * MiB;
constexpr size_t WS_OF = 633 * MiB;
constexpr size_t WS_OB = 665 * MiB;
constexpr size_t WS_OI = 697 * MiB;
constexpr size_t WS_QIN = 729 * MiB;
constexpr size_t WS_OG = 761 * MiB;
constexpr size_t WS_F = 793 * MiB;
constexpr size_t WS_OM = 809 * MiB;
constexpr size_t WS_MG = 825 * MiB;
constexpr size_t WS_MGB = 889 * MiB;
constexpr size_t WS_KST = 921 * MiB;
constexpr size_t WS_VT = 953 * MiB;
constexpr size_t WS_DD = 985 * MiB;
constexpr size_t WS_END = 986 * MiB;
constexpr int CW_TMO = 0, CW_BAR = 4096, CW_CNT = 16384;

constexpr int RING_BYTES = 131072, LDSCTL_OFF = 135168, MISC_OFF = LDSCTL_OFF + 1024, LDS_BYTES = 147456;

#define GAS __attribute__((address_space(1)))
#define LAS __attribute__((address_space(3)))
typedef unsigned short bf16;
typedef unsigned v4u __attribute__((ext_vector_type(4)));
typedef unsigned v2u __attribute__((ext_vector_type(2)));
typedef float f32x4 __attribute__((ext_vector_type(4)));
typedef short bf16x8 __attribute__((ext_vector_type(8)));
typedef GAS unsigned gu32;
#define RLX_AGENT __ATOMIC_RELAXED, __HIP_MEMORY_SCOPE_AGENT
#define LDS_WAIT() asm volatile("s_waitcnt lgkmcnt(0)" ::: "memory")
#define VM_WAIT() asm volatile("s_waitcnt vmcnt(0)" ::: "memory")
__device__ __forceinline__ unsigned f2bf(float f) { unsigned u = __builtin_bit_cast(unsigned, f); return (u + 0x7fffu + ((u >> 16) & 1u)) >> 16; }
__device__ __forceinline__ unsigned pk2(float lo, float hi) { return f2bf(lo) | (f2bf(hi) << 16); }
__device__ __forceinline__ float bf2f(unsigned b) { return __builtin_bit_cast(float, b << 16); }
__device__ __forceinline__ float bflo(unsigned w) { return __builtin_bit_cast(float, w << 16); }
__device__ __forceinline__ float bfhi(unsigned w) { return __builtin_bit_cast(float, w & 0xffff0000u); }

#define XB_TMO      128
#define XB_XCNT(j)  (256  + 64 * (j))
#define XB_XSUB(j)  (1280 + 64 * (j))
#define XB_XGEN(j)  (2304 + 64 * (j))
#define XB_TOP      3328
#define XB_TOPGEN   3392
#define XCD_BAR_WORDS 3456
#define XB_SPIN_CAP (1u << 22)
__device__ __forceinline__ unsigned xb_ld(unsigned* p)              { return __hip_atomic_load(p, __ATOMIC_RELAXED, __HIP_MEMORY_SCOPE_AGENT); }
__device__ __forceinline__ unsigned xb_add(unsigned* p, unsigned v) { return __hip_atomic_fetch_add(p, v, __ATOMIC_RELAXED, __HIP_MEMORY_SCOPE_AGENT); }
__device__ __forceinline__ unsigned xb_xcc_id() { return (unsigned)__builtin_amdgcn_s_getreg((3 << 11) | 20) & 0xFu; }
#define XB_SPIN(cond, bar) do { unsigned _sp = 0; while (cond) { __builtin_amdgcn_s_sleep(1); \
    if ((++_sp & 255u) == 0u) { if (xb_ld(&(bar)[XB_TMO])) break; if (_sp > XB_SPIN_CAP) { atomicAdd(&(bar)[XB_TMO], 1u); break; } } } } while (0)
struct XcdBarrier { unsigned* bar; unsigned x; volatile LAS unsigned* st; };
__device__ __forceinline__ XcdBarrier xcd_barrier_post(unsigned* bar, volatile LAS unsigned* st) {
    XcdBarrier b; b.bar = bar; b.x = xb_xcc_id(); b.st = st;
    if (threadIdx.x == 0) (void)xb_add(&bar[XB_XCNT(b.x)], 1u);
    return b;
}
__device__ __forceinline__ void xcd_barrier_complete(unsigned* bar, unsigned x, unsigned& nloc, unsigned& nx) {
    const unsigned G = gridDim.x * gridDim.y * gridDim.z;
    unsigned sum, cnt, mine, sp = 0u;
    for (;;) {
        sum = 0u; cnt = 0u; mine = 0u;
#pragma unroll
        for (unsigned j = 0; j < 16; ++j) { const unsigned c = xb_ld(&bar[XB_XCNT(j)]); sum += c; cnt += (c > 0u) ? 1u : 0u; mine = (j == x) ? c : mine; }
        if (sum == G) break;
        __builtin_amdgcn_s_sleep(1);
        if ((++sp & 255u) == 0u) { if (xb_ld(&bar[XB_TMO])) break; if (sp > XB_SPIN_CAP) { atomicAdd(&bar[XB_TMO], 1u); break; } }
    }
    nloc = mine > 0u ? mine : 1u; nx = cnt > 0u ? cnt : 1u;
}
__device__ __forceinline__ void xcd_barrier(const XcdBarrier& b) {
    asm volatile("s_waitcnt vmcnt(0)" ::: "memory");
    __syncthreads();
    if (threadIdx.x == 0) {
        unsigned* bar = b.bar;
        __builtin_amdgcn_s_waitcnt(0);
        unsigned nloc = b.st[0], nx = b.st[1];
        if (nloc == 0u) { xcd_barrier_complete(bar, b.x, nloc, nx); b.st[0] = nloc; b.st[1] = nx; }
        const unsigned old = xb_add(&bar[XB_XSUB(b.x)], 1u);
        const unsigned gen = old / nloc;
        if (old + 1u == (gen + 1u) * nloc) {
            __builtin_amdgcn_fence(__ATOMIC_RELEASE, "agent");
            asm volatile("s_waitcnt vmcnt(0)" ::: "memory");
            const unsigned og = xb_add(&bar[XB_TOP], 1u);
            const unsigned tg = og / nx;
            if (og + 1u == (tg + 1u) * nx) xb_add(&bar[XB_TOPGEN], 1u);
            else XB_SPIN(xb_ld(&bar[XB_TOPGEN]) == tg, bar);
            __builtin_amdgcn_fence(__ATOMIC_ACQUIRE, "agent");
            xb_add(&bar[XB_XGEN(b.x)], 1u);
            asm volatile("s_waitcnt vmcnt(0)" ::: "memory");
        } else {
            XB_SPIN(xb_ld(&bar[XB_XGEN(b.x)]) == gen, bar);
            __builtin_amdgcn_fence(__ATOMIC_ACQUIRE, "agent");
            asm volatile("s_waitcnt vmcnt(0)" ::: "memory");
        }
    }
    __syncthreads();
}

struct Frame {
    LAS unsigned char* lds;
    int tid, lane, wave, vcu, G;
    const float* in[29];
    float* out;
    unsigned char* ws;
};
#define WSP(T_, off) ((T_*)(F.ws + (off)))
__device__ __forceinline__ float wave_sum(float v) {
#pragma unroll
    for (int o = 1; o < 64; o <<= 1) v += __shfl_xor(v, o);
    return v;
}
__device__ __forceinline__ float wave_max(float v) {
#pragma unroll
    for (int o = 1; o < 64; o <<= 1) v = fmaxf(v, __shfl_xor(v, o));
    return v;
}

__device__ __forceinline__ void p0_transpose_item(const float* W, int K, int N, int k0, int n0, bf16* WT, int dst_row0, LAS float* scr, int lane) {
#pragma unroll 8
    for (int i = 0; i < 32; ++i) { const int kk = 2 * i + (lane >> 5); scr[kk * 33 + (lane & 31)] = W[(size_t)(k0 + kk) * N + n0 + (lane & 31)]; }
    LDS_WAIT(); asm volatile("" ::: "memory");
    const int c = lane & 7;
#pragma unroll
    for (int j = 0; j < 4; ++j) { const int n = (lane >> 3) + 8 * j; const LAS float* s = scr + (8 * c) * 33 + n;
        v4u o; o.x = pk2(s[0 * 33], s[1 * 33]); o.y = pk2(s[2 * 33], s[3 * 33]); o.z = pk2(s[4 * 33], s[5 * 33]); o.w = pk2(s[6 * 33], s[7 * 33]);
        *(GAS v4u*)(WT + (size_t)(dst_row0 + n) * K + k0 + 8 * c) = o; }
    LDS_WAIT(); asm volatile("" ::: "memory");
}
__device__ __forceinline__ void ln_row(const float* xrow, const float* g, const float* b, float* of32, bf16* obf, int lane, float pre_scale) {
    const GAS f32x4* xr = (const GAS f32x4*)xrow + lane;
    f32x4 v[4]; float s = 0.f;
#pragma unroll
    for (int j = 0; j < 4; ++j) { v[j] = xr[64 * j] * pre_scale; s += (v[j].x + v[j].y) + (v[j].z + v[j].w); }
    const float mean = wave_sum(s) * (1.f / D); float s2 = 0.f;
#pragma unroll
    for (int j = 0; j < 4; ++j) { v[j] = v[j] - mean; s2 += (v[j].x * v[j].x + v[j].y * v[j].y) + (v[j].z * v[j].z + v[j].w * v[j].w); }
    const float rstd = 1.f / sqrtf(wave_sum(s2) * (1.f / D) + LN_EPS);
#pragma unroll
    for (int j = 0; j < 4; ++j) { const f32x4 gg = ((const GAS f32x4*)g)[lane + 64 * j], bb = ((const GAS f32x4*)b)[lane + 64 * j]; v[j] = v[j] * rstd * gg + bb; }
    if (of32) { GAS f32x4* o = (GAS f32x4*)of32 + lane;
#pragma unroll
        for (int j = 0; j < 4; ++j) o[64 * j] = v[j]; }
    if (obf) { GAS unsigned long long* o8 = (GAS unsigned long long*)obf + lane;
#pragma unroll
        for (int j = 0; j < 4; ++j) o8[64 * j] = (unsigned long long)pk2(v[j].x, v[j].y) | ((unsigned long long)pk2(v[j].z, v[j].w) << 32); }
}

__device__ __forceinline__ void p0_prologue(Frame& F) {
    LAS float* scr = (LAS float*)(F.lds + F.wave * 16384);
    const int gw = F.vcu * NWAVES + F.wave, NGW = F.G * NWAVES;
    const int gt = F.vcu * 512 + F.tid, NGT = F.G * 512;
    constexpr int I_IN = 16 * 225, I_GLA = 16 * 32, I_FN = 8 * 32, I_MEM = 8 * 32, I_KV = 16 * 32, I_OUT = 16 * 32, I_RT = 16, I_GU = 32 * 16 * 64, I_DN = 32 * 16 * 32;
    constexpr int NITEMS = I_IN + I_GLA + I_FN + I_MEM + I_KV + I_OUT + I_RT + I_GU + I_DN;
    for (int it = gw; it < NITEMS; it += NGW) {
        int r = it;
        if (r < I_IN) { const int kb = r / 225, nb = r % 225; int dst;
            if (nb < 96) dst = nb * 32; else if (nb == 96) dst = LR_OFF; else if (nb < 113) continue; else if (nb < 129) dst = nb * 32 - MQ_SRC + MQ_OFF; else dst = nb * 32 - G_SRC + G_OFF;
            p0_transpose_item(F.in[6], 1024, IN_W, 64 * kb, 32 * nb, WSP(bf16, WS_WIN), dst, scr, F.lane); continue; } r -= I_IN;
        if (r < I_GLA) { p0_transpose_item(F.in[13], 1024, 1024, 64 * (r / 32), 32 * (r % 32), WSP(bf16, WS_WGLA), 32 * (r % 32), scr, F.lane); continue; } r -= I_GLA;
        if (r < I_FN) { p0_transpose_item(F.in[14], 512, 1024, 64 * (r / 32), 32 * (r % 32), WSP(bf16, WS_WFN), 32 * (r % 32), scr, F.lane); continue; } r -= I_FN;
        if (r < I_MEM) { p0_transpose_item(F.in[15], 512, 1024, 64 * (r / 32), 32 * (r % 32), WSP(bf16, WS_WMEM), 32 * (r % 32), scr, F.lane); continue; } r -= I_MEM;
        if (r < I_KV) { p0_transpose_item(F.in[16], 1024, 1024, 64 * (r / 32), 32 * (r % 32), WSP(bf16, WS_WKV), 32 * (r % 32), scr, F.lane); continue; } r -= I_KV;
        if (r < I_OUT) { p0_transpose_item(F.in[17], 1024, 1024, 64 * (r / 32), 32 * (r % 32), WSP(bf16, WS_WOUT), 32 * (r % 32), scr, F.lane); continue; } r -= I_OUT;
        if (r < I_RT) { p0_transpose_item(F.in[21], 1024, 32, 64 * r, 0, WSP(bf16, WS_WRT), 0, scr, F.lane); continue; } r -= I_RT;
        if (r < I_GU) { const int e = r / 1024, q = r % 1024, kb = q / 64, nb = q % 64, j = nb * 32;
            const int dst = (j < 1024) ? (j / 128) * 256 + (j % 128) : ((j - 1024) / 128) * 256 + 128 + ((j - 1024) % 128);
            p0_transpose_item(F.in[23] + (size_t)e * 1024 * 2048, 1024, 2048, 64 * kb, j, WSP(bf16, WS_WGU) + (size_t)e * 2048 * 1024, dst, scr, F.lane); continue; } r -= I_GU;
        { const int e = r / 512, q = r % 512, kb = q / 32, nb = q % 32;
            p0_transpose_item(F.in[25] + (size_t)e * 1024 * 1024, 1024, 1024, 64 * kb, 32 * nb, WSP(bf16, WS_WDN) + (size_t)e * 1024 * 1024, 32 * nb, scr, F.lane); }
    }
    { bf16* w = WSP(bf16, WS_WIN) + (size_t)(LR_OFF + 32) * 1024; for (int i = gt; i < (NP - LR_OFF - 32) * 1024 / 8; i += NGT) ((GAS v4u*)w)[i] = (v4u){0u, 0u, 0u, 0u}; }
    { float* bp = WSP(float, WS_BIN); const float* b = F.in[7];
      for (int i = gt; i < NP; i += NGT) { float v = 0.f;
          if (i < 3072) v = b[i]; else if (i < G_OFF) v = b[i - MQ_OFF + MQ_SRC]; else if (i < LR_OFF) v = b[i - G_OFF + G_SRC]; else if (i < LR_OFF + 32) v = b[i - LR_OFF + LR_SRC];
          bp[i] = v; } }
    { float* bp = WSP(float, WS_BGU); const float* b = F.in[24];
      for (int i = gt; i < NE * 2048; i += NGT) { const int e = i / 2048, d = i % 2048, pn = d / 256, w = d % 256; const int src = (w < 128) ? pn * 128 + w : 1024 + pn * 128 + (w - 128); bp[i] = b[e * 2048 + src]; } }
    __syncthreads();
    { LAS float* t128 = (LAS float*)F.lds;
      if (F.tid < 128) { float sn, cs; sincospif((float)F.tid * (1.0f / 64.0f), &sn, &cs); t128[2 * F.tid] = cs; t128[2 * F.tid + 1] = sn; }
      __syncthreads();
      bf16* wz = WSP(bf16, WS_WZ); const float* w = F.in[6]; const float rs = 0.08838834764831845f;
      for (int idx = gt; idx < 1024 * 512; idx += NGT) { const int k = idx & 1023, gc = idx >> 10, g = gc >> 7, cp = gc & 127;
          const float* src = w + (size_t)k * IN_W + FN_SRC + g * 128; float ar = 0.f, ai = 0.f;
          for (int c4 = 0; c4 < 32; ++c4) { const f32x4 x = *(const GAS f32x4*)(src + 4 * c4);
#pragma unroll
              for (int j = 0; j < 4; ++j) { const int mm = ((4 * c4 + j) * cp) & 127; const float cs = t128[2 * mm], sn = t128[2 * mm + 1]; ar += x[j] * cs; ai -= x[j] * sn; } }
          wz[(size_t)(gc * 2 + 0) * 1024 + k] = (bf16)f2bf(ar * rs); wz[(size_t)(gc * 2 + 1) * 1024 + k] = (bf16)f2bf(ai * rs); }
      float* bz = WSP(float, WS_BZ); const float* b = F.in[7];
      for (int gc = gt; gc < 512; gc += NGT) { const int g = gc >> 7, cp = gc & 127; float ar = 0.f, ai = 0.f;
          for (int c = 0; c < 128; ++c) { const int mm = (c * cp) & 127; const float cs = t128[2 * mm], sn = t128[2 * mm + 1]; const float x = b[FN_SRC + g * 128 + c]; ar += x * cs; ai -= x * sn; }
          bz[gc * 2] = ar * rs; bz[gc * 2 + 1] = ai * rs; } }
    __syncthreads();
    { LAS unsigned* tab = (LAS unsigned*)F.lds;
      for (int m = F.tid; m < 4096; m += 512) { float sn, cs; sincospif((float)m * (1.0f / 2048.0f), &sn, &cs); tab[m] = pk2(cs, sn); }
      __syncthreads();
      bf16* dft = WSP(bf16, WS_DFT);
      for (int idx = gt; idx < 4096 * 512; idx += NGT) { const int sp = idx >> 9, s0 = (idx & 511) * 8; unsigned cw[4], sw[4];
#pragma unroll
          for (int j = 0; j < 4; ++j) { const unsigned a = tab[((s0 + 2 * j) * sp) & 4095], b = tab[((s0 + 2 * j + 1) * sp) & 4095]; cw[j] = (a & 0xffffu) | (b << 16); sw[j] = (a >> 16) | (b & 0xffff0000u); }
          *(GAS v4u*)(dft + (size_t)sp * 8192 + s0) = (v4u){cw[0], cw[1], cw[2], cw[3]}; *(GAS v4u*)(dft + (size_t)sp * 8192 + 4096 + s0) = (v4u){sw[0], sw[1], sw[2], sw[3]}; }
      __syncthreads(); }
    for (int m = gw; m < T; m += NGW) ln_row(F.in[0] + (size_t)m * D, F.in[2], F.in[3], WSP(float, WS_H) + (size_t)m * D, WSP(bf16, WS_HB) + (size_t)m * D, F.lane, 1.0f);
    for (int m = gw; m < NB * MEM; m += NGW) ln_row(F.in[1] + (size_t)m * D, F.in[4], F.in[5], nullptr, WSP(bf16, WS_MEMN) + (size_t)m * D, F.lane, 1.0f);
}

using pg8::Unit; using pg8::cvt_pk_bf16;
struct EpiBias {
    static constexpr bool PERM = true;
    bf16* O; int ldc; const float* bias;
    __device__ __forceinline__ void operator()(const f32x4 (&acc)[2][2][4][2], const Unit& u, int wr, int wc, int fr, int fq) const {
        const int row0 = u.pm * 256 + wr * 64 + fr, col0 = u.pn * 256 + wc * 32 + 8 * fq;
        f32x4 bv[2][2];
#pragma unroll
        for (int bj = 0; bj < 2; ++bj)
#pragma unroll
            for (int n = 0; n < 2; ++n) bv[bj][n] = bias ? *(const f32x4*)(bias + col0 + bj * 128 + 4 * n) : (f32x4){0.f, 0.f, 0.f, 0.f};
#pragma unroll
        for (int ai = 0; ai < 2; ++ai)
#pragma unroll
            for (int m = 0; m < 4; ++m) { bf16* rowp = O + (size_t)(row0 + ai * 128 + m * 16) * ldc + col0;
#pragma unroll
                for (int bj = 0; bj < 2; ++bj) { const f32x4 v0 = acc[ai][bj][m][0] + bv[bj][0], v1 = acc[ai][bj][m][1] + bv[bj][1];
                    v4u w; w.x = cvt_pk_bf16(v0[0], v0[1]); w.y = cvt_pk_bf16(v0[2], v0[3]); w.z = cvt_pk_bf16(v1[0], v1[1]); w.w = cvt_pk_bf16(v1[2], v1[3]);
                    *(v4u*)(rowp + bj * 128) = w; } }
    }
};
struct EpiZT {
    static constexpr bool PERM = true;
    bf16* O; const float* bias;
    __device__ __forceinline__ void operator()(const f32x4 (&acc)[2][2][4][2], const Unit& u, int wr, int wc, int fr, int fq) const {
        const int row0 = u.pm * 256 + wr * 64 + fr, tok0 = u.pn * 256 + wc * 32 + 8 * fq, b = tok0 >> 12, s0 = tok0 & 4095;
#pragma unroll
        for (int ai = 0; ai < 2; ++ai)
#pragma unroll
            for (int m = 0; m < 4; ++m) { const int row = row0 + ai * 128 + m * 16; const float bz = bias[row]; bf16* rowp = O + ((size_t)b * 1024 + row) * 4096 + s0;
#pragma unroll
                for (int bj = 0; bj < 2; ++bj) { const f32x4 v0 = acc[ai][bj][m][0] + bz, v1 = acc[ai][bj][m][1] + bz;
                    v4u w; w.x = cvt_pk_bf16(v0[0], v0[1]); w.y = cvt_pk_bf16(v0[2], v0[3]); w.z = cvt_pk_bf16(v1[0], v1[1]); w.w = cvt_pk_bf16(v1[2], v1[3]);
                    *(v4u*)(rowp + bj * 128) = w; } }
    }
};
struct EpiFnet {
    static constexpr bool PERM = true;
    bf16* O;
    __device__ __forceinline__ void operator()(const f32x4 (&acc)[2][2][4][2], const Unit& u, int wr, int wc, int fr, int fq) const {
        const int row0 = u.z * 4096 + u.pm * 256 + wr * 64 + fr, col0 = u.pn * 256 + wc * 32 + 8 * fq;
#pragma unroll
        for (int ai = 0; ai < 2; ++ai)
#pragma unroll
            for (int m = 0; m < 4; ++m) { bf16* rowp = O + (size_t)(row0 + ai * 128 + m * 16) * 512 + col0;
#pragma unroll
                for (int bj = 0; bj < 2; ++bj) { const f32x4 v0 = acc[ai][bj][m][0] * 0.015625f, v1 = acc[ai][bj][m][1] * 0.015625f;
                    v4u w; w.x = cvt_pk_bf16(v0[0], v0[1]); w.y = cvt_pk_bf16(v0[2], v0[3]); w.z = cvt_pk_bf16(v1[0], v1[1]); w.w = cvt_pk_bf16(v1[2], v1[3]);
                    *(v4u*)(rowp + bj * 128) = w; } }
    }
};
template <int MODE> struct EpiGate {
    static constexpr bool PERM = true;
    float* MG; bf16* MGB; const bf16* gate;
    __device__ __forceinline__ void operator()(const f32x4 (&acc)[2][2][4][2], const Unit& u, int wr, int wc, int fr, int fq) const {
        const int row0 = u.pm * 256 + wr * 64 + fr, col0 = u.pn * 256 + wc * 32 + 8 * fq;
#pragma unroll
        for (int ai = 0; ai < 2; ++ai)
#pragma unroll
            for (int m = 0; m < 4; ++m) { const size_t row = (size_t)(row0 + ai * 128 + m * 16);
#pragma unroll
                for (int bj = 0; bj < 2; ++bj) { const int col = col0 + bj * 128;
                    const v4u gw = *(const v4u*)(gate + row * NP + col);
                    float gs[8] = {bflo(gw.x), bfhi(gw.x), bflo(gw.y), bfhi(gw.y), bflo(gw.z), bfhi(gw.z), bflo(gw.w), bfhi(gw.w)};
#pragma unroll
                    for (int j = 0; j < 8; ++j) gs[j] = 1.0f / (1.0f + __expf(-gs[j]));
                    f32x4 v0 = acc[ai][bj][m][0] * (f32x4){gs[0], gs[1], gs[2], gs[3]}, v1 = acc[ai][bj][m][1] * (f32x4){gs[4], gs[5], gs[6], gs[7]};
                    float* mp = MG + row * 1024 + col;
                    if (MODE >= 1) { v0 += *(const f32x4*)mp; v1 += *(const f32x4*)(mp + 4); }
                    if (MODE <= 1) { *(f32x4*)mp = v0; *(f32x4*)(mp + 4) = v1; }
                    else { v4u w; w.x = cvt_pk_bf16(v0[0], v0[1]); w.y = cvt_pk_bf16(v0[2], v0[3]); w.z = cvt_pk_bf16(v1[0], v1[1]); w.w = cvt_pk_bf16(v1[2], v1[3]); *(v4u*)(MGB + row * 1024 + col) = w; } } }
    }
};
struct EpiOut {
    static constexpr bool PERM = false;
    float* H; const float* bias;
    __device__ __forceinline__ void operator()(const f32x4 (&acc)[2][2][4][2], const Unit& u, int wr, int wc, int fr, int fq) const {
        const int row0 = u.pm * 256 + wr * 64 + fr, col0 = u.pn * 256 + wc * 32 + 4 * fq;
        f32x4 bv[2][2];
#pragma unroll
        for (int bj = 0; bj < 2; ++bj)
#pragma unroll
            for (int n = 0; n < 2; ++n) bv[bj][n] = *(const f32x4*)(bias + col0 + bj * 128 + n * 16);
#pragma unroll
        for (int ai = 0; ai < 2; ++ai)
#pragma unroll
            for (int m = 0; m < 4; ++m) { float* rowp = H + (size_t)(row0 + ai * 128 + m * 16) * 1024 + col0;
#pragma unroll
                for (int bj = 0; bj < 2; ++bj)
#pragma unroll
                    for (int n = 0; n < 2; ++n) { float* p = rowp + bj * 128 + n * 16; const f32x4 hv = *(const f32x4*)p; *(f32x4*)p = hv * DN_ALPHA + acc[ai][bj][m][n] + bv[bj][n]; } }
    }
};

template <int NPN, bool GATHER_> struct MoeSched {
    static constexpr bool GATHER = GATHER_;
    volatile LAS int* tb;
    const int* list;
    int G, c; int lda, ldb; size_t bstride;
    __device__ __forceinline__ bool next(int i, Unit& u) const {
        const int L = i * G + c, total = tb[64] * NPN; if (L >= total) return false;
        const int tl = L / NPN; int e = 0;
        for (int j = 1; j < 32; ++j) e += (tb[32 + j] <= tl) ? 1 : 0;
        const int te = tb[32 + e + 1] - tb[32 + e], idx = L - tb[32 + e] * NPN;
        u.z = e; u.pm = idx % te; u.pn = idx / te; return true;
    }
    __device__ __forceinline__ size_t a_off(const Unit& u) const { return (size_t)(tb[32 + u.z] + u.pm) * 256 * lda * 2; }
    __device__ __forceinline__ size_t b_off(const Unit& u) const { return (size_t)u.z * bstride + (size_t)u.pn * 256 * ldb * 2; }
    __device__ __forceinline__ unsigned gather_row(const Unit& u, int r) const {
        const int rr = u.pm * 256 + r; int tok = 0; if (rr < tb[u.z]) tok = list[u.z * T + rr] >> 2;
        return (unsigned)tok * (unsigned)(lda * 2);
    }
    __device__ __forceinline__ int row_base(const Unit& u) const { return (tb[32 + u.z] + u.pm) * 256; }
    __device__ __forceinline__ int nvalid(const Unit& u) const { return tb[u.z] - u.pm * 256; }
};
struct EpiSwiglu {
    static constexpr bool PERM = true;
    bf16* ACT; const float* bgu; MoeSched<8, true> S;
    __device__ __forceinline__ void operator()(const f32x4 (&acc)[2][2][4][2], const Unit& u, int wr, int wc, int fr, int fq) const {
        const int rbase = S.row_base(u) + wr * 64 + fr, cw = wc * 32 + 8 * fq;
        const float* bp = bgu + u.z * 2048 + u.pn * 256 + cw;
        const f32x4 bg0 = *(const f32x4*)bp, bg1 = *(const f32x4*)(bp + 4), bu0 = *(const f32x4*)(bp + 128), bu1 = *(const f32x4*)(bp + 132);
#pragma unroll
        for (int ai = 0; ai < 2; ++ai)
#pragma unroll
            for (int m = 0; m < 4; ++m) { const size_t row = (size_t)(rbase + ai * 128 + m * 16);
                float o[8];
#pragma unroll
                for (int n = 0; n < 2; ++n) { const f32x4 gt = acc[ai][0][m][n] + (n ? bg1 : bg0), up = acc[ai][1][m][n] + (n ? bu1 : bu0);
#pragma unroll
                    for (int j = 0; j < 4; ++j) { const float gg = fminf(gt[j], 7.0f), uu = fminf(fmaxf(up[j], -7.0f), 7.0f); o[4 * n + j] = (uu + 1.0f) * gg / (1.0f + __expf(-1.702f * gg)); } }
                v4u w; w.x = cvt_pk_bf16(o[0], o[1]); w.y = cvt_pk_bf16(o[2], o[3]); w.z = cvt_pk_bf16(o[4], o[5]); w.w = cvt_pk_bf16(o[6], o[7]);
                *(v4u*)(ACT + row * 1024 + u.pn * 128 + cw) = w; }
    }
};
struct EpiDown {
    static constexpr bool PERM = true;
    bf16* YB; const float* bd; const float* topw; const int* list; MoeSched<4, false> S;
    __device__ __forceinline__ void operator()(const f32x4 (&acc)[2][2][4][2], const Unit& u, int wr, int wc, int fr, int fq) const {
        const int nv = S.nvalid(u), col0 = u.pn * 256 + wc * 32 + 8 * fq;
        const float* bp = bd + u.z * 1024 + col0;
        f32x4 bv[2][2];
#pragma unroll
        for (int bj = 0; bj < 2; ++bj)
#pragma unroll
            for (int n = 0; n < 2; ++n) bv[bj][n] = *(const f32x4*)(bp + bj * 128 + 4 * n);
#pragma unroll
        for (int ai = 0; ai < 2; ++ai)
#pragma unroll
            for (int m = 0; m < 4; ++m) { const int r = ai * 128 + wr * 64 + m * 16 + fr;
                if (r < nv) { const int a = list[u.z * T + u.pm * 256 + r]; const float w = topw[a]; bf16* rowp = YB + (size_t)a * 1024 + col0;
#pragma unroll
                    for (int bj = 0; bj < 2; ++bj) { const f32x4 v0 = (acc[ai][bj][m][0] + bv[bj][0]) * w, v1 = (acc[ai][bj][m][1] + bv[bj][1]) * w;
                        v4u o; o.x = cvt_pk_bf16(v0[0], v0[1]); o.y = cvt_pk_bf16(v0[2], v0[3]); o.z = cvt_pk_bf16(v1[0], v1[1]); o.w = cvt_pk_bf16(v1[2], v1[3]);
                        *(v4u*)(rowp + bj * 128) = o; } } }
    }
};

typedef float f32x16 __attribute__((ext_vector_type(16)));
typedef float f32x2v __attribute__((ext_vector_type(2)));
typedef __bf16 bf16v2 __attribute__((ext_vector_type(2)));
__device__ __forceinline__ unsigned pkc(float lo, float hi) { return __builtin_bit_cast(unsigned, __builtin_convertvector((f32x2v){lo, hi}, bf16v2)); }
#define MFMA32(a, b, c) __builtin_amdgcn_mfma_f32_32x32x16_bf16((a), (b), (c), 0, 0, 0)
constexpr int G1_P = 272, G1_QF = 0, G1_KF = 17408, G1_QB = 34816, G1_KB = 52224, G1_VT = 69632, G1_VP = 144, G1_ATT = 106496, G1_LR = 115712, G1_TOT = 123904;
static_assert(G1_TOT + 8192 <= LDSCTL_OFF, "G1 LDS map");
__device__ __forceinline__ float logsig16(float z) { return (fminf(z, 0.f) - log1pf(__expf(-fabsf(z)))) * 0.0625f; }
__device__ __forceinline__ void gla_g1(Frame& F) {
    const bf16* proj = WSP(bf16, WS_PROJ);
    LAS unsigned char* L = F.lds;
    const int wave = F.wave;
    for (int unit = F.vcu; unit < 1024; unit += F.G) {
        int tid = F.tid; asm volatile("" : "+v"(tid));
        const int lane = tid & 63, l31 = lane & 31, hh = lane >> 5;
        const int n = unit & 63, bh = unit >> 6, h = bh & 3, b = bh >> 2;
        const size_t t0 = (size_t)b * SEQ + n * 64;
        __syncthreads();
        { const int row = tid >> 3, c4 = (tid & 7) * 4; const v2u w = *(const GAS v2u*)(proj + (t0 + row) * NP + LR_OFF + c4);
          LAS float* p = (LAS float*)(L + G1_LR) + row * 32 + c4; p[0] = bflo(w.x); p[1] = bfhi(w.x); p[2] = bflo(w.y); p[3] = bfhi(w.y); }
        { const int dvp = tid & 127, tg = tid >> 7; unsigned lo[8], hi[8];
#pragma unroll
          for (int t2 = 0; t2 < 8; ++t2) { const unsigned w0 = *(const GAS unsigned*)(proj + (t0 + 16 * tg + 2 * t2) * NP + V_OFF + h * 256 + 2 * dvp), w1 = *(const GAS unsigned*)(proj + (t0 + 16 * tg + 2 * t2 + 1) * NP + V_OFF + h * 256 + 2 * dvp);
              lo[t2] = (w0 & 0xffffu) | (w1 << 16); hi[t2] = (w0 >> 16) | (w1 & 0xffff0000u); }
          LAS unsigned char* p0 = L + G1_VT + (2 * dvp) * G1_VP + 32 * tg;
          *(LAS v4u*)p0 = (v4u){lo[0], lo[1], lo[2], lo[3]}; *(LAS v4u*)(p0 + 16) = (v4u){lo[4], lo[5], lo[6], lo[7]};
          *(LAS v4u*)(p0 + G1_VP) = (v4u){hi[0], hi[1], hi[2], hi[3]}; *(LAS v4u*)(p0 + G1_VP + 16) = (v4u){hi[4], hi[5], hi[6], hi[7]};
          bf16* vg = WSP(bf16, WS_VT) + ((size_t)bh * 64 + n) * 16384 + (2 * dvp) * 64 + 16 * tg;
          *(GAS v4u*)vg = (v4u){lo[0], lo[1], lo[2], lo[3]}; *(GAS v4u*)(vg + 8) = (v4u){lo[4], lo[5], lo[6], lo[7]};
          *(GAS v4u*)(vg + 64) = (v4u){hi[0], hi[1], hi[2], hi[3]}; *(GAS v4u*)(vg + 72) = (v4u){hi[4], hi[5], hi[6], hi[7]}; }
        __syncthreads();
        const int jp = tid & 63, ig = tid >> 6;
        float cf[8][2], cb[8][2];
#pragma unroll
        for (int dir = 0; dir < 2; ++dir) { const float* Wd = (dir ? F.in[10] : F.in[8]) + h * 128 + 2 * jp; const float* bd = (dir ? F.in[11] : F.in[9]) + h * 128 + 2 * jp;
            float w0[16], w1[16];
#pragma unroll
            for (int r = 0; r < 16; ++r) { const f32x2v w = *(const GAS f32x2v*)(Wd + r * 512); w0[r] = w.x; w1[r] = w.y; }
            const f32x2v bb = *(const GAS f32x2v*)bd;
#pragma unroll
            for (int rr = 0; rr < 8; ++rr) { const LAS f32x4* lr4 = (const LAS f32x4*)((LAS float*)(L + G1_LR) + (8 * ig + rr) * 32 + dir * 16); float z0 = bb.x, z1 = bb.y;
#pragma unroll
                for (int r4 = 0; r4 < 4; ++r4) { const f32x4 x = lr4[r4];
#pragma unroll
                    for (int j = 0; j < 4; ++j) { z0 += x[j] * w0[4 * r4 + j]; z1 += x[j] * w1[4 * r4 + j]; } }
                if (dir == 0) { cf[rr][0] = logsig16(z0); cf[rr][1] = logsig16(z1); } else { cb[rr][0] = logsig16(z0); cb[rr][1] = logsig16(z1); } }
        }
#pragma unroll
        for (int rr = 1; rr < 8; ++rr) { cf[rr][0] += cf[rr - 1][0]; cf[rr][1] += cf[rr - 1][1]; }
#pragma unroll
        for (int rr = 6; rr >= 0; --rr) { cb[rr][0] += cb[rr + 1][0]; cb[rr][1] += cb[rr + 1][1]; }
        { LAS float* tot = (LAS float*)(L + G1_TOT);
          *(LAS f32x2v*)(tot + (ig * 2 + 0) * 128 + 2 * jp) = (f32x2v){cf[7][0], cf[7][1]}; *(LAS f32x2v*)(tot + (ig * 2 + 1) * 128 + 2 * jp) = (f32x2v){cb[0][0], cb[0][1]}; }
        __syncthreads();
        float offf0 = 0.f, offf1 = 0.f, offb0 = 0.f, offb1 = 0.f, blf0 = 0.f, blf1 = 0.f, bb00 = 0.f, bb01 = 0.f;
        { const LAS float* tot = (const LAS float*)(L + G1_TOT);
#pragma unroll
          for (int g = 0; g < 8; ++g) { const f32x2v tf = *(const LAS f32x2v*)(tot + (g * 2 + 0) * 128 + 2 * jp), tb = *(const LAS f32x2v*)(tot + (g * 2 + 1) * 128 + 2 * jp);
              blf0 += tf.x; blf1 += tf.y; bb00 += tb.x; bb01 += tb.y;
              if (g < ig) { offf0 += tf.x; offf1 += tf.y; } if (g > ig) { offb0 += tb.x; offb1 += tb.y; } } }
        { const int blkf = ((bh * 2 + 0) * 64 + n), blkb = ((bh * 2 + 1) * 64 + n);
          bf16* qinf = WSP(bf16, WS_QIN) + (size_t)blkf * 8192; bf16* qinb = WSP(bf16, WS_QIN) + (size_t)blkb * 8192;
          float ksf0[8], ksf1[8], ksb0[8], ksb1[8];
#pragma unroll
          for (int rr = 0; rr < 8; ++rr) { const int row = 8 * ig + rr;
              const unsigned qw = *(const GAS unsigned*)(proj + (t0 + row) * NP + Q_OFF + h * 128 + 2 * jp), kw = *(const GAS unsigned*)(proj + (t0 + row) * NP + K_OFF + h * 128 + 2 * jp);
              const float q0 = bflo(qw) * 0.08838834764831845f, q1 = bfhi(qw) * 0.08838834764831845f, k0 = bflo(kw), k1 = bfhi(kw);
              const float f0 = cf[rr][0] + offf0, f1 = cf[rr][1] + offf1, g0 = cb[rr][0] + offb0, g1 = cb[rr][1] + offb1;
              const unsigned qf = pkc(q0 * __expf(f0), q1 * __expf(f1)), kf = pkc(k0 * __expf(-f0), k1 * __expf(-f1));
              const unsigned qb = pkc(q0 * __expf(g0), q1 * __expf(g1)), kb = pkc(k0 * __expf(-g0), k1 * __expf(-g1));
              *(LAS unsigned*)(L + G1_QF + row * G1_P + 4 * jp) = qf; *(LAS unsigned*)(L + G1_KF + row * G1_P + 4 * jp) = kf;
              *(LAS unsigned*)(L + G1_QB + row * G1_P + 4 * jp) = qb; *(LAS unsigned*)(L + G1_KB + row * G1_P + 4 * jp) = kb;
              *(GAS unsigned*)(qinf + row * 128 + 2 * jp) = qf; *(GAS unsigned*)(qinb + row * 128 + 2 * jp) = qb;
              ksf0[rr] = k0 * __expf(blf0 - f0); ksf1[rr] = k1 * __expf(blf1 - f1); ksb0[rr] = k0 * __expf(bb00 - g0); ksb1[rr] = k1 * __expf(bb01 - g1); }
          bf16* kstf = WSP(bf16, WS_KST) + (size_t)blkf * 8192 + (2 * jp) * 64 + 8 * ig; bf16* kstb = WSP(bf16, WS_KST) + (size_t)blkb * 8192 + (2 * jp) * 64 + 8 * ig;
          *(GAS v4u*)kstf = (v4u){pkc(ksf0[0], ksf0[1]), pkc(ksf0[2], ksf0[3]), pkc(ksf0[4], ksf0[5]), pkc(ksf0[6], ksf0[7])};
          *(GAS v4u*)(kstf + 64) = (v4u){pkc(ksf1[0], ksf1[1]), pkc(ksf1[2], ksf1[3]), pkc(ksf1[4], ksf1[5]), pkc(ksf1[6], ksf1[7])};
          *(GAS v4u*)kstb = (v4u){pkc(ksb0[0], ksb0[1]), pkc(ksb0[2], ksb0[3]), pkc(ksb0[4], ksb0[5]), pkc(ksb0[6], ksb0[7])};
          *(GAS v4u*)(kstb + 64) = (v4u){pkc(ksb1[0], ksb1[1]), pkc(ksb1[2], ksb1[3]), pkc(ksb1[4], ksb1[5]), pkc(ksb1[6], ksb1[7])};
          if (ig == 0) { float* dd = WSP(float, WS_DD); *(GAS f32x2v*)(dd + (size_t)blkf * 128 + 2 * jp) = (f32x2v){__expf(blf0), __expf(blf1)}; *(GAS f32x2v*)(dd + (size_t)blkb * 128 + 2 * jp) = (f32x2v){__expf(bb00), __expf(bb01)}; } }
        __syncthreads();
        if (wave < 4) { const int jt = (wave == 1 || wave == 3) ? 1 : 0, it = (wave == 1 || wave == 2) ? 1 : 0; const bool dof = (wave != 3), dob = (wave != 2);
            f32x16 xf, xb;
#pragma unroll
            for (int r = 0; r < 16; ++r) { xf[r] = 0.f; xb[r] = 0.f; }
            const int ao = (32 * jt + l31) * G1_P + 16 * hh, bo = (32 * it + l31) * G1_P + 16 * hh;
            if (dof) {
#pragma unroll
                for (int ks = 0; ks < 8; ++ks) xf = MFMA32(*(const LAS bf16x8*)(L + G1_KF + ao + 32 * ks), *(const LAS bf16x8*)(L + G1_QF + bo + 32 * ks), xf); }
            if (dob) {
#pragma unroll
                for (int ks = 0; ks < 8; ++ks) xb = MFMA32(*(const LAS bf16x8*)(L + G1_KB + ao + 32 * ks), *(const LAS bf16x8*)(L + G1_QB + bo + 32 * ks), xb); }
            const int i = 32 * it + l31;
#pragma unroll
            for (int g = 0; g < 4; ++g) { float vv[4];
#pragma unroll
                for (int e = 0; e < 4; ++e) { const int jq = 32 * jt + 8 * g + 4 * hh + e; vv[e] = ((dof && jq <= i) ? xf[4 * g + e] : 0.f) + ((dob && jq >= i) ? xb[4 * g + e] : 0.f); }
                *(LAS v2u*)(L + G1_ATT + i * G1_VP + (32 * jt + 8 * g + 4 * hh) * 2) = (v2u){pkc(vv[0], vv[1]), pkc(vv[2], vv[3])}; } }
        __syncthreads();
        { bf16* oi = WSP(bf16, WS_OI);
#pragma unroll
          for (int it = 0; it < 2; ++it) { f32x16 acc;
#pragma unroll
              for (int r = 0; r < 16; ++r) acc[r] = 0.f;
#pragma unroll
              for (int ks = 0; ks < 4; ++ks) acc = MFMA32(*(const LAS bf16x8*)(L + G1_ATT + (32 * it + l31) * G1_VP + 32 * ks + 16 * hh), *(const LAS bf16x8*)(L + G1_VT + (32 * wave + l31) * G1_VP + 32 * ks + 16 * hh), acc);
#pragma unroll
              for (int r = 0; r < 16; ++r) { const int i = 32 * it + (r & 3) + 8 * (r >> 2) + 4 * hh; oi[(t0 + i) * 1024 + h * 256 + 32 * wave + l31] = (bf16)f2bf(acc[r]); } } }
    }
    __syncthreads();
}
constexpr int G2_QIN = 0, G2_KST = 17408, G2_VT = 35840, G2_D = 54272, G2_BUF = 54784;
__device__ __forceinline__ void gla_g2(Frame& F, int wg) {
    const int half = wg & 1, bhd = wg >> 1, dir = bhd & 1, bh = bhd >> 1, h = bh & 3, b = bh >> 2;
    LAS unsigned char* L = F.lds;
    const int tid = F.tid, lane = F.lane, wave = F.wave, l31 = lane & 31, hh = lane >> 5;
    const bf16* qin = WSP(bf16, WS_QIN) + (size_t)(bhd * 64) * 8192; const bf16* kst = WSP(bf16, WS_KST) + (size_t)(bhd * 64) * 8192;
    const bf16* vt = WSP(bf16, WS_VT) + (size_t)(bh * 64) * 16384 + half * 8192; const float* dd = WSP(float, WS_DD) + (size_t)(bhd * 64) * 128;
    bf16* og = dir ? WSP(bf16, WS_OB) : WSP(bf16, WS_OF);
    v4u st[6]; v4u std_;
    const int p0 = tid, p1 = tid + 512;
    const int lq0 = G2_QIN + (p0 >> 4) * 272 + (p0 & 15) * 16, lq1 = G2_QIN + (p1 >> 4) * 272 + (p1 & 15) * 16;
    const int lk0 = (p0 >> 3) * 144 + (p0 & 7) * 16, lk1 = (p1 >> 3) * 144 + (p1 & 7) * 16;
#define G2_LOAD(c) do { const GAS v4u* q4 = (const GAS v4u*)(qin + (size_t)(c) * 8192); const GAS v4u* k4 = (const GAS v4u*)(kst + (size_t)(c) * 8192); const GAS v4u* v4 = (const GAS v4u*)(vt + (size_t)(c) * 16384); \
        st[0] = q4[p0]; st[1] = q4[p1]; st[2] = k4[p0]; st[3] = k4[p1]; st[4] = v4[p0]; st[5] = v4[p1]; if (tid < 32) std_ = ((const GAS v4u*)(dd + (size_t)(c) * 128))[tid]; } while (0)
#define G2_STORE(bufo) do { LAS unsigned char* B_ = L + (bufo); *(LAS v4u*)(B_ + lq0) = st[0]; *(LAS v4u*)(B_ + lq1) = st[1]; *(LAS v4u*)(B_ + G2_KST + lk0) = st[2]; *(LAS v4u*)(B_ + G2_KST + lk1) = st[3]; \
        *(LAS v4u*)(B_ + G2_VT + lk0) = st[4]; *(LAS v4u*)(B_ + G2_VT + lk1) = st[5]; if (tid < 32) *(LAS v4u*)(B_ + G2_D + 16 * tid) = std_; } while (0)
    f32x16 S0, S1, S2, S3;
#pragma unroll
    for (int r = 0; r < 16; ++r) { S0[r] = 0.f; S1[r] = 0.f; S2[r] = 0.f; S3[r] = 0.f; }
    bf16x8 Sb[4][2];
#pragma unroll
    for (int t = 0; t < 4; ++t)
#pragma unroll
        for (int s2 = 0; s2 < 2; ++s2) Sb[t][s2] = (bf16x8){0, 0, 0, 0, 0, 0, 0, 0};
    __syncthreads();
    { const int c0 = dir ? 63 : 0; G2_LOAD(c0); G2_STORE(0); }
    __syncthreads();
    for (int nn = 0; nn < 64; ++nn) {
        const int c = dir ? 63 - nn : nn; const int bufo = (nn & 1) * G2_BUF;
        if (nn + 1 < 64) { const int cn = dir ? 62 - nn : nn + 1; G2_LOAD(cn); }
        if (wave < 4) {
            const LAS unsigned char* B = L + bufo;
#pragma unroll
            for (int it = 0; it < 2; ++it) { f32x16 oacc;
#pragma unroll
                for (int r = 0; r < 16; ++r) oacc[r] = 0.f;
#pragma unroll
                for (int t = 0; t < 4; ++t)
#pragma unroll
                    for (int s2 = 0; s2 < 2; ++s2) { const LAS unsigned char* ap = B + G2_QIN + (32 * it + l31) * 272 + (32 * t + 16 * s2 + 4 * hh) * 2;
                        const v2u a_lo = *(const LAS v2u*)ap, a_hi = *(const LAS v2u*)(ap + 16);
                        const bf16x8 af = __builtin_bit_cast(bf16x8, (v4u){a_lo.x, a_lo.y, a_hi.x, a_hi.y});
                        oacc = MFMA32(af, Sb[t][s2], oacc); }
                const size_t tb = (size_t)b * SEQ + c * 64;
#pragma unroll
                for (int r = 0; r < 16; ++r) { const int i = 32 * it + (r & 3) + 8 * (r >> 2) + 4 * hh; og[(tb + i) * 1024 + h * 256 + half * 128 + 32 * wave + l31] = (bf16)f2bf(oacc[r]); } }
#define G2_UPD(SX, t) do { _Pragma("unroll") for (int g = 0; g < 4; ++g) { const f32x4 d4 = *(const LAS f32x4*)(B + G2_D + (32 * (t) + 8 * g + 4 * hh) * 4); \
                SX[4 * g] *= d4[0]; SX[4 * g + 1] *= d4[1]; SX[4 * g + 2] *= d4[2]; SX[4 * g + 3] *= d4[3]; } \
            _Pragma("unroll") for (int ks = 0; ks < 4; ++ks) SX = MFMA32(*(const LAS bf16x8*)(B + G2_KST + (32 * (t) + l31) * 144 + 32 * ks + 16 * hh), *(const LAS bf16x8*)(B + G2_VT + (32 * wave + l31) * 144 + 32 * ks + 16 * hh), SX); \
            _Pragma("unroll") for (int s2 = 0; s2 < 2; ++s2) Sb[t][s2] = __builtin_bit_cast(bf16x8, (v4u){pkc(SX[8 * s2], SX[8 * s2 + 1]), pkc(SX[8 * s2 + 2], SX[8 * s2 + 3]), pkc(SX[8 * s2 + 4], SX[8 * s2 + 5]), pkc(SX[8 * s2 + 6], SX[8 * s2 + 7])}); } while (0)
            G2_UPD(S0, 0); G2_UPD(S1, 1); G2_UPD(S2, 2); G2_UPD(S3, 3);
#undef G2_UPD
        }
        if (nn + 1 < 64) G2_STORE(((nn + 1) & 1) * G2_BUF);
        __syncthreads();
    }
#undef G2_LOAD
#undef G2_STORE
}

__device__ __forceinline__ void gla_finalize(Frame& F) {
    const int gw = F.vcu * NWAVES + F.wave, NGW = F.G * NWAVES;
    const bf16* oi = WSP(bf16, WS_OI); const bf16* of = WSP(bf16, WS_OF); const bf16* ob = WSP(bf16, WS_OB); const bf16* proj = WSP(bf16, WS_PROJ); bf16* og = WSP(bf16, WS_OG);
    const f32x4 gg = ((const GAS f32x4*)F.in[12])[F.lane];
    for (int t = gw; t < T; t += NGW) {
#pragma unroll
        for (int j = 0; j < 4; ++j) { const size_t o = (size_t)t * 1024 + 256 * j + 4 * F.lane;
            const v2u a = *(const GAS v2u*)(oi + o), bq = *(const GAS v2u*)(of + o), c = *(const GAS v2u*)(ob + o);
            f32x4 v = (f32x4){bflo(a.x) + bflo(bq.x) + bflo(c.x), bfhi(a.x) + bfhi(bq.x) + bfhi(c.x), bflo(a.y) + bflo(bq.y) + bflo(c.y), bfhi(a.y) + bfhi(bq.y) + bfhi(c.y)};
            const float ms = wave_sum((v.x * v.x + v.y * v.y) + (v.z * v.z + v.w * v.w)) * (1.0f / 256.0f); const float rs = 1.0f / sqrtf(ms + RMS_EPS);
            const v2u rw = *(const GAS v2u*)(proj + (size_t)t * NP + R_OFF + 256 * j + 4 * F.lane);
            const float r0 = bflo(rw.x), r1 = bfhi(rw.x), r2 = bflo(rw.y), r3 = bfhi(rw.y);
            v = v * rs * gg;
            v.x *= r0 / (1.0f + __expf(-r0)); v.y *= r1 / (1.0f + __expf(-r1)); v.z *= r2 / (1.0f + __expf(-r2)); v.w *= r3 / (1.0f + __expf(-r3));
            *(GAS v2u*)(og + o) = (v2u){pk2(v.x, v.y), pk2(v.z, v.w)}; }
    }
}

constexpr int XA_KP = 272, XA_VP = 528;
__device__ __forceinline__ void xattn_mfma(Frame& F) {
    const bf16* proj = WSP(bf16, WS_PROJ); const bf16* kg = WSP(bf16, WS_KV); const bf16* vtg = kg + 1024 * 512; bf16* om = WSP(bf16, WS_OM);
    LAS unsigned char* L = F.lds; const int wave = F.wave;
    for (int unit = F.vcu; unit < 256; unit += F.G) {
        int tid = F.tid; asm volatile("" : "+v"(tid));
        const int lane = tid & 63, l31 = lane & 31, hh = lane >> 5;
        const int qt = unit & 15, bh = unit >> 4, h = bh & 3, b = bh >> 2;
        const size_t t0 = (size_t)b * SEQ + qt * 256 + 32 * wave;
        __syncthreads();
#pragma unroll
        for (int j = 0; j < 8; ++j) { const int p = tid + 512 * j, row = p >> 4, pc = p & 15; *(LAS v4u*)(L + row * XA_KP + pc * 16) = *(const GAS v4u*)(kg + (size_t)(b * 256 + row) * 512 + h * 128 + pc * 8); }
        bf16x8 qf[8];
#pragma unroll
        for (int ks = 0; ks < 8; ++ks) qf[ks] = *(const GAS bf16x8*)(proj + (t0 + l31) * NP + MQ_OFF + h * 128 + 16 * ks + 8 * hh);
        __syncthreads();
        f32x16 X[8];
#pragma unroll
        for (int kt = 0; kt < 8; ++kt) {
#pragma unroll
            for (int r = 0; r < 16; ++r) X[kt][r] = 0.f;
#pragma unroll
            for (int ks = 0; ks < 8; ++ks) X[kt] = MFMA32(*(const LAS bf16x8*)(L + (32 * kt + l31) * XA_KP + 32 * ks + 16 * hh), qf[ks], X[kt]); }
        float mx = -3.0e38f;
#pragma unroll
        for (int kt = 0; kt < 8; ++kt)
#pragma unroll
            for (int r = 0; r < 16; ++r) mx = fmaxf(mx, X[kt][r]);
        mx = fmaxf(mx, __shfl_xor(mx, 32));
        float sm = 0.f;
#pragma unroll
        for (int kt = 0; kt < 8; ++kt)
#pragma unroll
            for (int r = 0; r < 16; ++r) { X[kt][r] = __expf((X[kt][r] - mx) * 0.08838834764831845f); sm += X[kt][r]; }
        sm += __shfl_xor(sm, 32);
        const float inv = 1.0f / sm;
        bf16x8 P[8][2];
#pragma unroll
        for (int kt = 0; kt < 8; ++kt)
#pragma unroll
            for (int s2 = 0; s2 < 2; ++s2) P[kt][s2] = __builtin_bit_cast(bf16x8, (v4u){pkc(X[kt][8 * s2] * inv, X[kt][8 * s2 + 1] * inv), pkc(X[kt][8 * s2 + 2] * inv, X[kt][8 * s2 + 3] * inv), pkc(X[kt][8 * s2 + 4] * inv, X[kt][8 * s2 + 5] * inv), pkc(X[kt][8 * s2 + 6] * inv, X[kt][8 * s2 + 7] * inv)});
        __syncthreads();
#pragma unroll
        for (int j = 0; j < 8; ++j) { const int p = tid + 512 * j, d = p >> 5, pc = p & 31; *(LAS v4u*)(L + d * XA_VP + pc * 16) = *(const GAS v4u*)(vtg + (size_t)(h * 128 + d) * 1024 + b * 256 + pc * 8); }
        __syncthreads();
#pragma unroll
        for (int dt = 0; dt < 4; ++dt) { f32x16 o;
#pragma unroll
            for (int r = 0; r < 16; ++r) o[r] = 0.f;
#pragma unroll
            for (int kt = 0; kt < 8; ++kt)
#pragma unroll
                for (int s2 = 0; s2 < 2; ++s2) { const LAS unsigned char* bp = L + (32 * dt + l31) * XA_VP + (32 * kt + 16 * s2 + 4 * hh) * 2;
                    const v2u b_lo = *(const LAS v2u*)bp, b_hi = *(const LAS v2u*)(bp + 16);
                    o = MFMA32(P[kt][s2], __builtin_bit_cast(bf16x8, (v4u){b_lo.x, b_lo.y, b_hi.x, b_hi.y}), o); }
#pragma unroll
            for (int r = 0; r < 16; ++r) { const int i = (r & 3) + 8 * (r >> 2) + 4 * hh; om[(t0 + i) * 512 + h * 128 + 32 * dt + l31] = (bf16)f2bf(o[r]); } }
    }
    __syncthreads();
}

__device__ __forceinline__ void router_phase(Frame& F) {
    LAS int* hist = (LAS int*)(F.lds);
    const bf16* h1b = WSP(bf16, WS_HB); const bf16* wrt = WSP(bf16, WS_WRT); const float* brt = F.in[22];
    int* list = WSP(int, WS_RT); float* topw = WSP(float, WS_TOPW); unsigned* cnt = (unsigned*)(F.ws + WS_CTL) + CW_CNT;
    const int tq = F.lane & 15, q = F.lane >> 4;
    for (int it = F.vcu; it < T / 128; it += F.G) {
        if (F.tid < 64) hist[F.tid] = 0;
        __syncthreads();
        const int tok = it * 128 + F.wave * 16 + tq;
        f32x4 a0 = {0.f, 0.f, 0.f, 0.f}, a1 = {0.f, 0.f, 0.f, 0.f};
        const bf16* ap0 = wrt + (size_t)tq * 1024 + 8 * q; const bf16* ap1 = wrt + (size_t)(16 + tq) * 1024 + 8 * q; const bf16* bp = h1b + (size_t)tok * 1024 + 8 * q;
#pragma unroll 4
        for (int ks = 0; ks < 32; ++ks) { const bf16x8 bf = *(const GAS bf16x8*)(bp + 32 * ks);
            a0 = __builtin_amdgcn_mfma_f32_16x16x32_bf16(*(const GAS bf16x8*)(ap0 + 32 * ks), bf, a0, 0, 0, 0);
            a1 = __builtin_amdgcn_mfma_f32_16x16x32_bf16(*(const GAS bf16x8*)(ap1 + 32 * ks), bf, a1, 0, 0, 0); }
        float lv[8]; int taken = 0;
#pragma unroll
        for (int r = 0; r < 4; ++r) { lv[r] = a0[r] + brt[4 * q + r]; lv[4 + r] = a1[r] + brt[16 + 4 * q + r]; }
        float tv[4]; int te[4];
#pragma unroll
        for (int k = 0; k < 4; ++k) { float bv = -3.0e38f; int be = 64;
#pragma unroll
            for (int r = 0; r < 8; ++r) { const int e = (r < 4) ? 4 * q + r : 16 + 4 * q + (r - 4); const bool ok = !((taken >> r) & 1) && (lv[r] > bv || (lv[r] == bv && e < be)); bv = ok ? lv[r] : bv; be = ok ? e : be; }
#pragma unroll
            for (int o = 16; o < 64; o <<= 1) { const float ov = __shfl_xor(bv, o); const int oe = __shfl_xor(be, o); const bool tk = (ov > bv) || (ov == bv && oe < be); bv = tk ? ov : bv; be = tk ? oe : be; }
            tv[k] = bv; te[k] = be;
#pragma unroll
            for (int r = 0; r < 8; ++r) { const int e = (r < 4) ? 4 * q + r : 16 + 4 * q + (r - 4); if (e == be) taken |= (1 << r); } }
        const float e1 = __expf(tv[1] - tv[0]), e2 = __expf(tv[2] - tv[0]), e3 = __expf(tv[3] - tv[0]); const float inv = 1.0f / (1.0f + e1 + e2 + e3);
        const float wk = (q == 0 ? 1.0f : q == 1 ? e1 : q == 2 ? e2 : e3) * inv; const int ek = (q == 0 ? te[0] : q == 1 ? te[1] : q == 2 ? te[2] : te[3]);
        const int a = tok * 4 + q;
        const int lpos = __hip_atomic_fetch_add(&hist[ek], 1, __ATOMIC_RELAXED, __HIP_MEMORY_SCOPE_WORKGROUP);
        __syncthreads();
        if (F.tid < 32) hist[32 + F.tid] = (int)__hip_atomic_fetch_add(cnt + F.tid, (unsigned)hist[F.tid], RLX_AGENT);
        __syncthreads();
        list[ek * T + hist[32 + ek] + lpos] = a; topw[a] = wk;
        __syncthreads();
    }
}

__device__ __forceinline__ void final_phase(Frame& F) {
    const int gw = F.vcu * NWAVES + F.wave, NGW = F.G * NWAVES;
    const float* h1 = WSP(float, WS_H); const bf16* yb = WSP(bf16, WS_YB);
    for (int t = gw; t < T; t += NGW) {
        f32x4 v[4]; float s = 0.f;
#pragma unroll
        for (int j = 0; j < 4; ++j) { v[j] = ((const GAS f32x4*)(h1 + (size_t)t * 1024))[F.lane + 64 * j] * DN_ALPHA;
#pragma unroll
            for (int k = 0; k < 4; ++k) { const v2u w = *(const GAS v2u*)(yb + ((size_t)t * 4 + k) * 1024 + 256 * j + 4 * F.lane); v[j] += (f32x4){bflo(w.x), bfhi(w.x), bflo(w.y), bfhi(w.y)}; }
            s += (v[j].x + v[j].y) + (v[j].z + v[j].w); }
        const float mean = wave_sum(s) * (1.f / D); float s2 = 0.f;
#pragma unroll
        for (int j = 0; j < 4; ++j) { v[j] = v[j] - mean; s2 += (v[j].x * v[j].x + v[j].y * v[j].y) + (v[j].z * v[j].z + v[j].w * v[j].w); }
        const float rstd = 1.f / sqrtf(wave_sum(s2) * (1.f / D) + LN_EPS);
#pragma unroll
        for (int j = 0; j < 4; ++j) { const f32x4 gg = ((const GAS f32x4*)F.in[27])[F.lane + 64 * j], bb = ((const GAS f32x4*)F.in[28])[F.lane + 64 * j];
            ((GAS f32x4*)(F.out + (size_t)t * 1024))[F.lane + 64 * j] = v[j] * rstd * gg + bb; }
    }
}

struct Args { const float* in[29]; float* out; unsigned char* ws; int ph_lo, ph_hi, li, pad; };
__global__ void __launch_bounds__(NWAVES * 64, 2) mega_fwd(Args args) {
    extern __shared__ __attribute__((aligned(16))) unsigned char lds[];
    Frame F;
    F.lds = (LAS unsigned char*)lds;
    F.tid = threadIdx.x; F.lane = F.tid & 63; F.wave = __builtin_amdgcn_readfirstlane(F.tid >> 6);
    F.G = gridDim.x; { const int bx = blockIdx.x; F.vcu = (F.G % 8 == 0) ? (bx % 8) * (F.G / 8) + bx / 8 : bx; }
#pragma unroll
    for (int i = 0; i < 29; ++i) F.in[i] = args.in[i];
    F.out = args.out; F.ws = args.ws;
    volatile LAS unsigned* MISC = (volatile LAS unsigned*)(F.lds + MISC_OFF);
    for (int u = F.tid; u < (LDS_BYTES - LDSCTL_OFF) / 4; u += NWAVES * 64) ((LAS unsigned*)(F.lds + LDSCTL_OFF))[u] = 0u;
    __syncthreads();
    unsigned* ctl = (unsigned*)(F.ws + WS_CTL);
    XcdBarrier bar; bar.bar = ctl + CW_BAR; bar.x = 0; bar.st = nullptr;
#if !MK_PER_PHASE
    bar = xcd_barrier_post(ctl + CW_BAR, MISC + 8);
#define GRID_BAR() xcd_barrier(bar)
#else
#define GRID_BAR() do {} while (0)
#endif
    const int lo = args.ph_lo, hi = args.ph_hi;
#ifndef PH_MASK
#define PH_MASK 0xfff
#endif
#define IN(k) (((PH_MASK >> (k)) & 1) && lo <= (k) && (k) < hi)
#define BOTH(k) (IN(k) && IN((k) + 1))
    const int bx = (int)blockIdx.x;

    if (IN(0)) { p0_prologue(F); if (BOTH(0)) GRID_BAR(); }

    if (IN(1)) {
        { pg8::Gemm g{WSP(bf16, WS_HB), WSP(bf16, WS_WIN), D, D, D}; pg8::StaticOrder S; S.init(T, NP, F.G, bx, D, D);
          EpiBias E{WSP(bf16, WS_PROJ), NP, WSP(float, WS_BIN)}; pg8::gemm_phase(F.lds, g, S, E); }
        { pg8::Gemm g{WSP(bf16, WS_WZ), WSP(bf16, WS_HB), D, D, D}; pg8::StaticOrder S; S.init(1024, T, F.G, bx, D, D);
          EpiZT E{WSP(bf16, WS_ZT), WSP(float, WS_BZ)}; pg8::gemm_phase(F.lds, g, S, E); }
        { pg8::Gemm g{WSP(bf16, WS_MEMN), WSP(bf16, WS_WKV), D, D, D}; pg8::StaticOrder S; S.init(NB * MEM, 512, F.G, F.G - 1 - bx, D, D);
          EpiBias E{WSP(bf16, WS_KV), 512, nullptr}; pg8::gemm_phase(F.lds, g, S, E); }
        { pg8::Gemm g{WSP(bf16, WS_WKV) + 512 * 1024, WSP(bf16, WS_MEMN), D, D, D}; pg8::StaticOrder S; S.init(512, NB * MEM, F.G, F.G - 9 - bx, D, D);
          EpiBias E{WSP(bf16, WS_KV) + 1024 * 512, 1024, nullptr}; pg8::gemm_phase(F.lds, g, S, E); }
        if (BOTH(1)) GRID_BAR();
    }

    if (IN(2)) {
        gla_g1(F);
        xattn_mfma(F);
        if (BOTH(2)) GRID_BAR();
    }

    if (IN(3)) {
        if (bx < 64) gla_g2(F, bx);
        __syncthreads();
        { pg8::Gemm g{WSP(bf16, WS_DFT), WSP(bf16, WS_ZT), 8192, 8192, 8192}; pg8::StaticOrder S; S.init(SEQ, 512, F.G, F.G - 1 - bx, 8192, 8192, NB, 0, (size_t)512 * 8192 * 2);
          EpiFnet E{WSP(bf16, WS_F)}; pg8::gemm_phase(F.lds, g, S, E); }
        if (BOTH(3)) GRID_BAR();
    }

    if (IN(4)) { gla_finalize(F); if (BOTH(4)) GRID_BAR(); }

    if (IN(5)) {
        const bf16* gate = WSP(bf16, WS_PROJ) + G_OFF;
        { pg8::Gemm g{WSP(bf16, WS_OG), WSP(bf16, WS_WGLA), 1024, 1024, 1024}; pg8::StaticOrder S; S.init(T, D, F.G, bx, 1024, 1024);
          EpiGate<0> E{WSP(float, WS_MG), WSP(bf16, WS_MGB), gate}; pg8::gemm_phase(F.lds, g, S, E); }
        { pg8::Gemm g{WSP(bf16, WS_F), WSP(bf16, WS_WFN), 512, 512, 512}; pg8::StaticOrder S; S.init(T, D, F.G, bx, 512, 512);
          EpiGate<1> E{WSP(float, WS_MG), WSP(bf16, WS_MGB), gate + 1024}; pg8::gemm_phase(F.lds, g, S, E); }
        { pg8::Gemm g{WSP(bf16, WS_OM), WSP(bf16, WS_WMEM), 512, 512, 512}; pg8::StaticOrder S; S.init(T, D, F.G, bx, 512, 512);
          EpiGate<2> E{WSP(float, WS_MG), WSP(bf16, WS_MGB), gate + 2048}; pg8::gemm_phase(F.lds, g, S, E); }
        if (BOTH(5)) GRID_BAR();
    }

    if (IN(6)) {
        pg8::Gemm g{WSP(bf16, WS_MGB), WSP(bf16, WS_WOUT), 1024, 1024, 1024}; pg8::StaticOrder S; S.init(T, D, F.G, bx, 1024, 1024);
        EpiOut E{WSP(float, WS_H), F.in[18]}; pg8::gemm_phase(F.lds, g, S, E);
        if (BOTH(6)) GRID_BAR();
    }

    if (IN(7)) {
        const int gw = F.vcu * NWAVES + F.wave, NGW = F.G * NWAVES;
        for (int m = gw; m < T; m += NGW) ln_row(WSP(float, WS_H) + (size_t)m * D, F.in[19], F.in[20], WSP(float, WS_H) + (size_t)m * D, WSP(bf16, WS_HB) + (size_t)m * D, F.lane, 1.0f);
        if (BOTH(7)) GRID_BAR();
    }

    if (IN(8)) { router_phase(F); if (BOTH(8)) GRID_BAR(); }

    if (IN(9) || IN(10)) {
        volatile LAS int* tb = (volatile LAS int*)(F.lds + MISC_OFF + 256);
        __syncthreads();
        if (F.tid == 0) { const unsigned* cnt = ctl + CW_CNT; int acc = 0;
            for (int e = 0; e < 32; ++e) { const int c = (int)__hip_atomic_load(cnt + e, RLX_AGENT); tb[e] = c; tb[32 + e] = acc; acc += (c + 255) >> 8; }
            tb[64] = acc; }
        __syncthreads();
        if (IN(9)) {
            MoeSched<8, true> S; S.tb = tb; S.list = WSP(int, WS_RT); S.G = F.G; S.c = bx; S.lda = 1024; S.ldb = 1024; S.bstride = (size_t)2048 * 1024 * 2;
            pg8::Gemm g{WSP(bf16, WS_HB), WSP(bf16, WS_WGU), 1024, 1024, 1024};
            EpiSwiglu E{WSP(bf16, WS_ACT), WSP(float, WS_BGU), S}; pg8::gemm_phase(F.lds, g, S, E);
            if (BOTH(9)) GRID_BAR();
        }
        if (IN(10)) {
            MoeSched<4, false> S; S.tb = tb; S.list = WSP(int, WS_RT); S.G = F.G; S.c = bx; S.lda = 1024; S.ldb = 1024; S.bstride = (size_t)1024 * 1024 * 2;
            pg8::Gemm g{WSP(bf16, WS_ACT), WSP(bf16, WS_WDN), 1024, 1024, 1024};
            EpiDown E{WSP(bf16, WS_YB), F.in[26], WSP(float, WS_TOPW), WSP(int, WS_RT), S}; pg8::gemm_phase(F.lds, g, S, E);
            if (BOTH(10)) GRID_BAR();
        }
    }

    if (IN(11)) final_phase(F);
#undef IN
#undef BOTH
}

extern "C" void kernel_launch(void* const* d_in, const int* in_sizes, int n_in, void* d_out, int out_size, void* d_ws, size_t ws_size, hipStream_t stream) {
    static int grid = 0;
    if (grid == 0) {
        if (n_in != 29 || out_size != T * D || ws_size < WS_END) { fprintf(stderr, "kernel_launch: unexpected shapes (n_in %d out %d ws %zu need %zu)\n", n_in, out_size, ws_size, (size_t)WS_END); grid = -1; return; }
        int dev = 0, cus = 0, per_cu = 0;
        if (hipGetDevice(&dev) != hipSuccess || hipDeviceGetAttribute(&cus, hipDeviceAttributeMultiprocessorCount, dev) != hipSuccess) { grid = -1; return; }
        if (hipFuncSetAttribute((const void*)mega_fwd, hipFuncAttributeMaxDynamicSharedMemorySize, LDS_BYTES) != hipSuccess) { fprintf(stderr, "kernel_launch: hipFuncSetAttribute failed\n"); grid = -1; return; }
        if (hipOccupancyMaxActiveBlocksPerMultiprocessor(&per_cu, (const void*)mega_fwd, NWAVES * 64, LDS_BYTES) != hipSuccess || per_cu < 1) fprintf(stderr, "kernel_launch: occupancy query says %d\n", per_cu);
        (void)hipGetLastError();
        grid = cus;
    }
    if (grid < 0) return;
    (void)in_sizes;
    if (hipMemsetAsync((char*)d_ws + WS_CTL, 0, CTL_ZERO_BYTES, stream) != hipSuccess) return;
    Args a{};
    for (int i = 0; i < 29; ++i) a.in[i] = (const float*)d_in[i];
    a.out = (float*)d_out; a.ws = (unsigned char*)d_ws;
#if MK_PER_PHASE
    for (int p = 0; p < N_PHASES; ++p) { a.ph_lo = p; a.ph_hi = p + 1; a.li = p; hipLaunchKernelGGL(mega_fwd, dim3(grid), dim3(NWAVES * 64), LDS_BYTES, stream, a); }
#else
    a.ph_lo = 0; a.ph_hi = N_PHASES; a.li = 0;
    hipLaunchKernelGGL(mega_fwd, dim3(grid), dim3(NWAVES * 64), LDS_BYTES, stream, a);
#endif
}
```

```cpp
#include <hip/hip_runtime.h>
#include <cstdio>
#include <cstdint>

#ifndef MK_PER_PHASE
#define MK_PER_PHASE 0
#endif

namespace pg8 {
#define PG8_LAS __attribute__((address_space(3)))
typedef unsigned short bf16_t;
typedef short bf16x8 __attribute__((ext_vector_type(8)));
typedef float f32x4 __attribute__((ext_vector_type(4)));
typedef float f32x2 __attribute__((ext_vector_type(2)));
typedef unsigned u32x4 __attribute__((ext_vector_type(4)));
typedef unsigned u32x2 __attribute__((ext_vector_type(2)));
constexpr int BM = 256, BK = 64, HALF = 128, HTB = HALF * BK * 2, STAGE_BYTES = 8 * HTB, NXCD = 8, WGM = 8;

__host__ __device__ __forceinline__ int lds_byte(int r, int c) { const int st = (r >> 4) * 2 + (c >> 5), rr = r & 15, cc = c & 31, ob = rr * 64 + cc * 2; return st * 1024 + (ob ^ (((ob >> 9) & 1) << 5)); }
__host__ __device__ __forceinline__ void stage_rc(int b, int& R, int& C) { const int st = b / 1024, sb = b % 1024, swz = sb ^ (((sb >> 9) & 1) << 5); R = (st >> 1) * 16 + swz / 64; C = (st & 1) * 32 + (swz % 64) / 2; }
__host__ __device__ __forceinline__ int perm32(int rho) { const int n = rho >> 4, i = rho & 15; return 8 * (i >> 2) + 4 * n + (i & 3); }

struct Unit { int pm, pn, z; };
struct Gemm { const bf16_t* A; const bf16_t* Bt; int lda, ldb, K; };

struct StaticOrder {
    static constexpr bool GATHER = false;
    int nM, nN, nwg, G, c, nz; size_t az, bz;
    int lda, ldb;
    __device__ void init(int M, int N, int G_, int c_, int lda_, int ldb_, int nz_ = 1, size_t az_ = 0, size_t bz_ = 0) { nM = M / BM; nN = N / BM; nwg = nM * nN; G = G_; c = c_; nz = nz_; az = az_; bz = bz_; lda = lda_; ldb = ldb_; }
    __device__ bool next(int i, Unit& u) const {
        const long L = (long)i * G + c; if (c < 0 || L >= (long)nwg * nz) return false;
        int wgid = (int)(L % nwg); u.z = (int)(L / nwg);
        { const int q = nwg / NXCD, r = nwg % NXCD, xcd = wgid % NXCD, off = wgid / NXCD; wgid = (xcd < r ? xcd * (q + 1) : r * (q + 1) + (xcd - r) * q) + off; }
        const int nig = WGM * nN, gid = wgid / nig, fm = gid * WGM, gsz = (nM - fm) < WGM ? (nM - fm) : WGM;
        u.pm = fm + ((wgid % nig) % gsz); u.pn = (wgid % nig) / gsz; return true;
    }
    __device__ __forceinline__ size_t a_off(const Unit& u) const { return (size_t)u.z * az + (size_t)u.pm * BM * lda * 2; }
    __device__ __forceinline__ size_t b_off(const Unit& u) const { return (size_t)u.z * bz + (size_t)u.pn * BM * ldb * 2; }
    __device__ __forceinline__ unsigned gather_row(const Unit&, int) const { return 0u; }
};

__device__ __forceinline__ unsigned cvt_pk_bf16(float lo, float hi) { unsigned r; asm volatile("v_cvt_pk_bf16_f32 %0, %1, %2" : "=v"(r) : "v"(lo), "v"(hi)); return r; }

template <class Epi, class Sched>
__device__ __forceinline__ void gemm_phase(PG8_LAS unsigned char* lds, const Gemm g, const Sched& S, const Epi& E) {
    constexpr bool GA = Sched::GATHER;
    const int tid = threadIdx.x, wid = __builtin_amdgcn_readfirstlane(tid >> 6), lane = tid & 63, wr = wid >> 2, wc = wid & 3, fr = lane & 15, fq = lane >> 4;
    const int K = g.K, nt = K / BK;
    unsigned voffA[2], voffB[2]; int RA[2], CA[2];
#pragma unroll
    for (int i = 0; i < 2; ++i) { int R, C; stage_rc(tid * 16 + i * 8192, R, C); const int Rb = Epi::PERM ? ((R & ~31) + perm32(R & 31)) : R;
        RA[i] = R; CA[i] = C; voffA[i] = (unsigned)(R * g.lda + C) * 2u; voffB[i] = (unsigned)(Rb * g.ldb + C) * 2u; }
    const size_t kstep = (size_t)(BK * 2);
    const size_t hstepA = GA ? 0 : (size_t)HALF * g.lda * 2, hstepB = (size_t)HALF * g.ldb * 2;
    const unsigned ldsw = (unsigned)wid * 1024u;
    const int aoff = lds_byte(wr * 64 + fr, fq * 8), boff = lds_byte(wc * 32 + fr, fq * 8);
    unsigned vgc[2][2], vgn[2][2];
#define PG8_SA(b, h) (((b) * 2 + (h)) * HTB)
#define PG8_SB(b, h) ((4 + (b) * 2 + (h)) * HTB)
#define PG8_STAGE(bufoff, gbase, voff) do { _Pragma("unroll") for (int _i = 0; _i < 2; ++_i) \
        __builtin_amdgcn_global_load_lds((const unsigned*)((const char*)(gbase) + (voff)[_i]), (PG8_LAS unsigned*)(lds + (bufoff) + ldsw + _i * 8192), 16, 0, 0); } while (0)
#define PG8_STAGE_A(bufoff, gbase, h, nx) do { if constexpr (GA) { unsigned _v[2]; _v[0] = (nx) ? vgn[h][0] : vgc[h][0]; _v[1] = (nx) ? vgn[h][1] : vgc[h][1]; PG8_STAGE(bufoff, gbase, _v); } \
        else { PG8_STAGE(bufoff, (gbase) + (h) * hstepA, voffA); } } while (0)
#define PG8_LDA(dst, b, h) do { _Pragma("unroll") for (int m = 0; m < 4; ++m) _Pragma("unroll") for (int k = 0; k < 2; ++k) dst[m][k] = *(const PG8_LAS bf16x8*)(lds + PG8_SA(b, h) + aoff + m * 2048 + k * 1024); } while (0)
#define PG8_LDB(dst, b, h) do { _Pragma("unroll") for (int n = 0; n < 2; ++n) _Pragma("unroll") for (int k = 0; k < 2; ++k) dst[n][k] = *(const PG8_LAS bf16x8*)(lds + PG8_SB(b, h) + boff + n * 2048 + k * 1024); } while (0)
#define PG8_MMA(ai, bj, At, Bt) do { __builtin_amdgcn_s_setprio(1); _Pragma("unroll") for (int m = 0; m < 4; ++m) _Pragma("unroll") for (int n = 0; n < 2; ++n) _Pragma("unroll") for (int k = 0; k < 2; ++k) \
        acc[ai][bj][m][n] = __builtin_amdgcn_mfma_f32_16x16x32_bf16(Bt[n][k], At[m][k], acc[ai][bj][m][n], 0, 0, 0); __builtin_amdgcn_s_setprio(0); } while (0)
#define PG8_WAIT_V(n) asm volatile("s_waitcnt vmcnt(" #n ")" ::: "memory")
#define PG8_WAIT_L(n) asm volatile("s_waitcnt lgkmcnt(" #n ")" ::: "memory")
#define PG8_BAR __builtin_amdgcn_s_barrier()
#define PG8_SCHED __builtin_amdgcn_sched_barrier(0)
    Unit cur, nxt; int ui = 0;
    if (!S.next(0, cur)) return;
    f32x4 acc[2][2][4][2];
#pragma unroll
    for (int a = 0; a < 2; ++a)
#pragma unroll
        for (int b = 0; b < 2; ++b)
#pragma unroll
            for (int m = 0; m < 4; ++m)
#pragma unroll
                for (int n = 0; n < 2; ++n) acc[a][b][m][n] = (f32x4){0.f, 0.f, 0.f, 0.f};
    bf16x8 At[4][2], B0[2][2], B1[2][2];
    const char* cA = (const char*)g.A + (GA ? 0 : S.a_off(cur)); const char* cB = (const char*)g.Bt + S.b_off(cur);
    if constexpr (GA) {
#pragma unroll
        for (int h = 0; h < 2; ++h)
#pragma unroll
            for (int i = 0; i < 2; ++i) { vgc[h][i] = S.gather_row(cur, h * HALF + RA[i]) + (unsigned)CA[i] * 2u; vgn[h][i] = vgc[h][i]; }
    }
    PG8_STAGE(PG8_SB(0, 0), cB, voffB); PG8_STAGE(PG8_SB(0, 1), cB + hstepB, voffB); PG8_STAGE_A(PG8_SA(0, 0), cA, 0, false); PG8_STAGE_A(PG8_SA(0, 1), cA, 1, false);
    if (wr == 1) PG8_BAR;
    PG8_WAIT_V(2); PG8_BAR;
    PG8_STAGE(PG8_SB(1, 0), cB + kstep, voffB); PG8_STAGE_A(PG8_SA(1, 0), cA + kstep, 0, false); PG8_STAGE(PG8_SB(1, 1), cB + hstepB + kstep, voffB);
    PG8_WAIT_V(6); PG8_BAR;
    for (;;) {
        const bool has_next = S.next(ui + 1, nxt);
        const char* nA = has_next ? (const char*)g.A + (GA ? 0 : S.a_off(nxt)) : cA; const char* nB = has_next ? (const char*)g.Bt + S.b_off(nxt) : cB;
        if constexpr (GA) { if (has_next) {
#pragma unroll
            for (int h = 0; h < 2; ++h)
#pragma unroll
                for (int i = 0; i < 2; ++i) vgn[h][i] = S.gather_row(nxt, h * HALF + RA[i]) + (unsigned)CA[i] * 2u; } }
        for (int t = 0; t < nt; t += 2) {
            const bool last = (t == nt - 2);
            const char* a1 = cA + (size_t)(t + 1) * kstep;
            const char* a2 = last ? nA : cA + (size_t)(t + 2) * kstep; const char* b2 = last ? nB : cB + (size_t)(t + 2) * kstep;
            const char* a3 = a2 + kstep; const char* b3 = b2 + kstep;
            PG8_LDB(B0, 0, 0); PG8_LDB(B1, 0, 1); PG8_SCHED; PG8_LDA(At, 0, 0); PG8_STAGE_A(PG8_SA(1, 1), a1, 1, false);
            PG8_WAIT_V(8); PG8_WAIT_L(0); PG8_BAR; PG8_MMA(0, 0, At, B0); PG8_MMA(0, 1, At, B1); PG8_BAR; PG8_SCHED;
            PG8_LDA(At, 0, 1); PG8_STAGE(PG8_SB(0, 0), b2, voffB); PG8_STAGE(PG8_SB(0, 1), b2 + hstepB, voffB); PG8_STAGE_A(PG8_SA(0, 0), a2, 0, last);
            PG8_WAIT_V(8); PG8_WAIT_L(0); PG8_BAR; PG8_MMA(1, 0, At, B0); PG8_MMA(1, 1, At, B1); PG8_BAR; PG8_SCHED;
            PG8_LDB(B0, 1, 0); PG8_LDB(B1, 1, 1); PG8_SCHED; PG8_LDA(At, 1, 0); PG8_STAGE_A(PG8_SA(0, 1), a2, 1, last);
            PG8_WAIT_V(8); PG8_WAIT_L(0); PG8_BAR; PG8_MMA(0, 0, At, B0); PG8_MMA(0, 1, At, B1); PG8_BAR; PG8_SCHED;
            PG8_LDA(At, 1, 1); PG8_STAGE(PG8_SB(1, 0), b3, voffB); PG8_STAGE(PG8_SB(1, 1), b3 + hstepB, voffB); PG8_STAGE_A(PG8_SA(1, 0), a3, 0, last);
            PG8_WAIT_V(8); PG8_WAIT_L(0); PG8_BAR; PG8_MMA(1, 0, At, B0); PG8_MMA(1, 1, At, B1); PG8_BAR; PG8_SCHED;
        }
        if (wr == 0) PG8_BAR;
        E(acc, cur, wr, wc, fr, fq);
        if (!has_next) break;
#pragma unroll
        for (int a = 0; a < 2; ++a)
#pragma unroll
            for (int b = 0; b < 2; ++b)
#pragma unroll
                for (int m = 0; m < 4; ++m)
#pragma unroll
                    for (int n = 0; n < 2; ++n) acc[a][b][m][n] = (f32x4){0.f, 0.f, 0.f, 0.f};
        cur = nxt; cA = nA; cB = nB; ++ui;
        if constexpr (GA) {
#pragma unroll
            for (int h = 0; h < 2; ++h)
#pragma unroll
                for (int i = 0; i < 2; ++i) vgc[h][i] = vgn[h][i]; }
        if (wr == 1) PG8_BAR;
    }
    PG8_WAIT_V(0);
    PG8_BAR;
#undef PG8_SA
#undef PG8_SB
#undef PG8_STAGE
#undef PG8_STAGE_A
#undef PG8_LDA
#undef PG8_LDB
#undef PG8_MMA
#undef PG8_WAIT_V
#undef PG8_WAIT_L
#undef PG8_BAR
#undef PG8_SCHED
}
}

constexpr int NWAVES = 8;
constexpr int T = 16384, D = 1024, NB = 4, SEQ = 4096, NP = 6912, MEM = 256;
constexpr int Q_OFF = 0, K_OFF = 512, V_OFF = 1024, R_OFF = 2048, MQ_OFF = 3072, G_OFF = 3584, LR_OFF = 6656;
constexpr int IN_W = 7200, LR_SRC = 3072, FN_SRC = 3104, MQ_SRC = 3616, G_SRC = 4128;
constexpr int NE = 32, DFF = 1024, ACT_ROWS = 73728;
constexpr float LN_EPS = 1e-5f, RMS_EPS = 1e-6f;
constexpr float DN_ALPHA = 1.18920711500272f;
constexpr int N_PHASES = 12;

constexpr size_t MiB = 1u << 20;
constexpr size_t WS_CTL = 0, CTL_ZERO_BYTES = 1 * MiB;
constexpr size_t WS_WIN = 1 * MiB;
constexpr size_t WS_WZ = 15 * MiB;
constexpr size_t WS_WKV = 17 * MiB;
constexpr size_t WS_WGLA = 19 * MiB;
constexpr size_t WS_WFN = 21 * MiB;
constexpr size_t WS_WMEM = 22 * MiB;
constexpr size_t WS_WOUT = 23 * MiB;
constexpr size_t WS_WRT = 25 * MiB;
constexpr size_t WS_BIN = WS_WRT + 65536;
constexpr size_t WS_BZ = WS_BIN + 32768;
constexpr size_t WS_BGU = WS_BZ + 4096;
constexpr size_t WS_WGU = 26 * MiB;
constexpr size_t WS_WDN = 154 * MiB;
constexpr size_t WS_H = 218 * MiB;
constexpr size_t WS_HB = 282 * MiB;
constexpr size_t WS_MEMN = 314 * MiB;
constexpr size_t WS_KV = 316 * MiB;
constexpr size_t WS_RT = 318 * MiB;
constexpr size_t WS_TOPW = WS_RT + 2 * MiB;
constexpr size_t WS_PROJ = 321 * MiB;
constexpr size_t WS_ZT = 537 * MiB;
constexpr size_t WS_DFT = 569 * MiB;
constexpr size_t WS_ACT = 321 * MiB;
constexpr size_t WS_YB = 465 * MiB;
constexpr size_t WS_OF = 633 * MiB;
constexpr size_t WS_OB = 665 * MiB;
constexpr size_t WS_OI = 697 * MiB;
constexpr size_t WS_QIN = 729 * MiB;
constexpr size_t WS_OG = 761 * MiB;
constexpr size_t WS_F = 793 * MiB;
constexpr size_t WS_OM = 809 * MiB;
constexpr size_t WS_MG = 825 * MiB;
constexpr size_t WS_MGB = 889 * MiB;
constexpr size_t WS_KST = 921 * MiB;
constexpr size_t WS_VT = 953 * MiB;
constexpr size_t WS_DD = 985 * MiB;
constexpr size_t WS_END = 986 * MiB;
constexpr int CW_TMO = 0, CW_BAR = 4096, CW_CNT = 16384;

constexpr int RING_BYTES = 131072, LDSCTL_OFF = 135168, MISC_OFF = LDSCTL_OFF + 1024, LDS_BYTES = 147456;

#define GAS __attribute__((address_space(1)))
#define LAS __attribute__((address_space(3)))
typedef unsigned short bf16;
typedef unsigned v4u __attribute__((ext_vector_type(4)));
typedef unsigned v2u __attribute__((ext_vector_type(2)));
typedef float f32x4 __attribute__((ext_vector_type(4)));
typedef short bf16x8 __attribute__((ext_vector_type(8)));
typedef GAS unsigned gu32;
#define RLX_AGENT __ATOMIC_RELAXED, __HIP_MEMORY_SCOPE_AGENT
#define LDS_WAIT() asm volatile("s_waitcnt lgkmcnt(0)" ::: "memory")
#define VM_WAIT() asm volatile("s_waitcnt vmcnt(0)" ::: "memory")
__device__ __forceinline__ unsigned f2bf(float f) { unsigned u = __builtin_bit_cast(unsigned, f); return (u + 0x7fffu + ((u >> 16) & 1u)) >> 16; }
__device__ __forceinline__ unsigned pk2(float lo, float hi) { return f2bf(lo) | (f2bf(hi) << 16); }
__device__ __forceinline__ float bf2f(unsigned b) { return __builtin_bit_cast(float, b << 16); }
__device__ __forceinline__ float bflo(unsigned w) { return __builtin_bit_cast(float, w << 16); }
__device__ __forceinline__ float bfhi(unsigned w) { return __builtin_bit_cast(float, w & 0xffff0000u); }

#define XB_TMO      128
#define XB_XCNT(j)  (256  + 64 * (j))
#define XB_XSUB(j)  (1280 + 64 * (j))
#define XB_XGEN(j)  (2304 + 64 * (j))
#define XB_TOP      3328
#define XB_TOPGEN   3392
#define XCD_BAR_WORDS 3456
#define XB_SPIN_CAP (1u << 22)
__device__ __forceinline__ unsigned xb_ld(unsigned* p)              { return __hip_atomic_load(p, __ATOMIC_RELAXED, __HIP_MEMORY_SCOPE_AGENT); }
__device__ __forceinline__ unsigned xb_add(unsigned* p, unsigned v) { return __hip_atomic_fetch_add(p, v, __ATOMIC_RELAXED, __HIP_MEMORY_SCOPE_AGENT); }
__device__ __forceinline__ unsigned xb_xcc_id() { return (unsigned)__builtin_amdgcn_s_getreg((3 << 11) | 20) & 0xFu; }
#define XB_SPIN(cond, bar) do { unsigned _sp = 0; while (cond) { __builtin_amdgcn_s_sleep(1); \
    if ((++_sp & 255u) == 0u) { if (xb_ld(&(bar)[XB_TMO])) break; if (_sp > XB_SPIN_CAP) { atomicAdd(&(bar)[XB_TMO], 1u); break; } } } } while (0)
struct XcdBarrier { unsigned* bar; unsigned x; volatile LAS unsigned* st; };
__device__ __forceinline__ XcdBarrier xcd_barrier_post(unsigned* bar, volatile LAS unsigned* st) {
    XcdBarrier b; b.bar = bar; b.x = xb_xcc_id(); b.st = st;
    if (threadIdx.x == 0) (void)xb_add(&bar[XB_XCNT(b.x)], 1u);
    return b;
}
__device__ __forceinline__ void xcd_barrier_complete(unsigned* bar, unsigned x, unsigned& nloc, unsigned& nx) {
    const unsigned G = gridDim.x * gridDim.y * gridDim.z;
    unsigned sum, cnt, mine, sp = 0u;
    for (;;) {
        sum = 0u; cnt = 0u; mine = 0u;
#pragma unroll
        for (unsigned j = 0; j < 16; ++j) { const unsigned c = xb_ld(&bar[XB_XCNT(j)]); sum += c; cnt += (c > 0u) ? 1u : 0u; mine = (j == x) ? c : mine; }
        if (sum == G) break;
        __builtin_amdgcn_s_sleep(1);
        if ((++sp & 255u) == 0u) { if (xb_ld(&bar[XB_TMO])) break; if (sp > XB_SPIN_CAP) { atomicAdd(&bar[XB_TMO], 1u); break; } }
    }
    nloc = mine > 0u ? mine : 1u; nx = cnt > 0u ? cnt : 1u;
}
__device__ __forceinline__ void xcd_barrier(const XcdBarrier& b) {
    asm volatile("s_waitcnt vmcnt(0)" ::: "memory");
    __syncthreads();
    if (threadIdx.x == 0) {
        unsigned* bar = b.bar;
        __builtin_amdgcn_s_waitcnt(0);
        unsigned nloc = b.st[0], nx = b.st[1];
        if (nloc == 0u) { xcd_barrier_complete(bar, b.x, nloc, nx); b.st[0] = nloc; b.st[1] = nx; }
        const unsigned old = xb_add(&bar[XB_XSUB(b.x)], 1u);
        const unsigned gen = old / nloc;
        if (old + 1u == (gen + 1u) * nloc) {
            __builtin_amdgcn_fence(__ATOMIC_RELEASE, "agent");
            asm volatile("s_waitcnt vmcnt(0)" ::: "memory");
            const unsigned og = xb_add(&bar[XB_TOP], 1u);
            const unsigned tg = og / nx;
            if (og + 1u == (tg + 1u) * nx) xb_add(&bar[XB_TOPGEN], 1u);
            else XB_SPIN(xb_ld(&bar[XB_TOPGEN]) == tg, bar);
            __builtin_amdgcn_fence(__ATOMIC_ACQUIRE, "agent");
            xb_add(&bar[XB_XGEN(b.x)], 1u);
            asm volatile("s_waitcnt vmcnt(0)" ::: "memory");
        } else {
            XB_SPIN(xb_ld(&bar[XB_XGEN(b.x)]) == gen, bar);
            __builtin_amdgcn_fence(__ATOMIC_ACQUIRE, "agent");
            asm volatile("s_waitcnt vmcnt(0)" ::: "memory");
        }
    }
    __syncthreads();
}

struct Frame {
    LAS unsigned char* lds;
    int tid, lane, wave, vcu, G;
    const float* in[29];
    float* out;
    unsigned char* ws;
};
#define WSP(T_, off) ((T_*)(F.ws + (off)))
__device__ __forceinline__ float wave_sum(float v) {
#pragma unroll
    for (int o = 1; o < 64; o <<= 1) v += __shfl_xor(v, o);
    return v;
}
__device__ __forceinline__ float wave_max(float v) {
#pragma unroll
    for (int o = 1; o < 64; o <<= 1) v = fmaxf(v, __shfl_xor(v, o));
    return v;
}

__device__ __forceinline__ void p0_cvt_item(const float* W, int K, int N, int k0, int n0, bf16* WT, int dst_row0, int lane) {
    const int kg = lane >> 3, n4 = (lane & 7) * 4;
    const float* src = W + (size_t)(k0 + 8 * kg) * N + n0 + n4;
    f32x4 v[8];
#pragma unroll
    for (int j = 0; j < 8; ++j) v[j] = *(const GAS f32x4*)(src + (size_t)j * N);
#pragma unroll
    for (int c = 0; c < 4; ++c) { v4u o; o.x = pk2(v[0][c], v[1][c]); o.y = pk2(v[2][c], v[3][c]); o.z = pk2(v[4][c], v[5][c]); o.w = pk2(v[6][c], v[7][c]);
        *(GAS v4u*)(WT + (size_t)(dst_row0 + n4 + c) * K + k0 + 8 * kg) = o; }
}
__device__ __forceinline__ void ln_row(const float* xrow, const float* g, const float* b, float* of32, bf16* obf, int lane, float pre_scale) {
    const GAS f32x4* xr = (const GAS f32x4*)xrow + lane;
    f32x4 v[4]; float s = 0.f;
#pragma unroll
    for (int j = 0; j < 4; ++j) { v[j] = xr[64 * j] * pre_scale; s += (v[j].x + v[j].y) + (v[j].z + v[j].w); }
    const float mean = wave_sum(s) * (1.f / D); float s2 = 0.f;
#pragma unroll
    for (int j = 0; j < 4; ++j) { v[j] = v[j] - mean; s2 += (v[j].x * v[j].x + v[j].y * v[j].y) + (v[j].z * v[j].z + v[j].w * v[j].w); }
    const float rstd = 1.f / sqrtf(wave_sum(s2) * (1.f / D) + LN_EPS);
#pragma unroll
    for (int j = 0; j < 4; ++j) { const f32x4 gg = ((const GAS f32x4*)g)[lane + 64 * j], bb = ((const GAS f32x4*)b)[lane + 64 * j]; v[j] = v[j] * rstd * gg + bb; }
    if (of32) { GAS f32x4* o = (GAS f32x4*)of32 + lane;
#pragma unroll
        for (int j = 0; j < 4; ++j) o[64 * j] = v[j]; }
    if (obf) { GAS unsigned long long* o8 = (GAS unsigned long long*)obf + lane;
#pragma unroll
        for (int j = 0; j < 4; ++j) o8[64 * j] = (unsigned long long)pk2(v[j].x, v[j].y) | ((unsigned long long)pk2(v[j].z, v[j].w) << 32); }
}

__device__ __forceinline__ void moe_weight_cvt(Frame& F, int wv, int nw) {
    constexpr int I_GU = 32 * 16 * 64, I_DN = 32 * 16 * 32;
    for (int it = wv; it < I_GU + I_DN; it += nw) {
        int r = it;
        if (r < I_GU) { const int e = r / 1024, q = r % 1024, kb = q / 64, nb = q % 64, j = nb * 32;
            const int dst = (j < 1024) ? (j / 128) * 256 + (j % 128) : ((j - 1024) / 128) * 256 + 128 + ((j - 1024) % 128);
            p0_cvt_item(F.in[23] + (size_t)e * 1024 * 2048, 1024, 2048, 64 * kb, j, WSP(bf16, WS_WGU) + (size_t)e * 2048 * 1024, dst, F.lane); continue; } r -= I_GU;
        { const int e = r / 512, q = r % 512, kb = q / 32, nb = q % 32;
            p0_cvt_item(F.in[25] + (size_t)e * 1024 * 1024, 1024, 1024, 64 * kb, 32 * nb, WSP(bf16, WS_WDN) + (size_t)e * 1024 * 1024, 32 * nb, F.lane); }
    }
}
__device__ __forceinline__ void p0_prologue(Frame& F) {
    const int gw = F.vcu * NWAVES + F.wave, NGW = F.G * NWAVES;
    const int gt = F.vcu * 512 + F.tid, NGT = F.G * 512;
    constexpr int I_IN = 16 * 225, I_GLA = 16 * 32, I_FN = 8 * 32, I_MEM = 8 * 32, I_KV = 16 * 32, I_OUT = 16 * 32, I_RT = 16;
    constexpr int NITEMS = I_IN + I_GLA + I_FN + I_MEM + I_KV + I_OUT + I_RT;
    for (int it = gw; it < NITEMS; it += NGW) {
        int r = it;
        if (r < I_IN) { const int kb = r / 225, nb = r % 225; int dst;
            if (nb < 96) dst = nb * 32; else if (nb == 96) dst = LR_OFF; else if (nb < 113) continue; else if (nb < 129) dst = nb * 32 - MQ_SRC + MQ_OFF; else dst = nb * 32 - G_SRC + G_OFF;
            p0_cvt_item(F.in[6], 1024, IN_W, 64 * kb, 32 * nb, WSP(bf16, WS_WIN), dst, F.lane); continue; } r -= I_IN;
        if (r < I_GLA) { p0_cvt_item(F.in[13], 1024, 1024, 64 * (r / 32), 32 * (r % 32), WSP(bf16, WS_WGLA), 32 * (r % 32), F.lane); continue; } r -= I_GLA;
        if (r < I_FN) { p0_cvt_item(F.in[14], 512, 1024, 64 * (r / 32), 32 * (r % 32), WSP(bf16, WS_WFN), 32 * (r % 32), F.lane); continue; } r -= I_FN;
        if (r < I_MEM) { p0_cvt_item(F.in[15], 512, 1024, 64 * (r / 32), 32 * (r % 32), WSP(bf16, WS_WMEM), 32 * (r % 32), F.lane); continue; } r -= I_MEM;
        if (r < I_KV) { p0_cvt_item(F.in[16], 1024, 1024, 64 * (r / 32), 32 * (r % 32), WSP(bf16, WS_WKV), 32 * (r % 32), F.lane); continue; } r -= I_KV;
        if (r < I_OUT) { p0_cvt_item(F.in[17], 1024, 1024, 64 * (r / 32), 32 * (r % 32), WSP(bf16, WS_WOUT), 32 * (r % 32), F.lane); continue; } r -= I_OUT;
        { p0_cvt_item(F.in[21], 1024, 32, 64 * r, 0, WSP(bf16, WS_WRT), 0, F.lane); }
    }
    { bf16* w = WSP(bf16, WS_WIN) + (size_t)(LR_OFF + 32) * 1024; for (int i = gt; i < (NP - LR_OFF - 32) * 1024 / 8; i += NGT) ((GAS v4u*)w)[i] = (v4u){0u, 0u, 0u, 0u}; }
    { float* bp = WSP(float, WS_BIN); const float* b = F.in[7];
      for (int i = gt; i < NP; i += NGT) { float v = 0.f;
          if (i < 3072) v = b[i]; else if (i < G_OFF) v = b[i - MQ_OFF + MQ_SRC]; else if (i < LR_OFF) v = b[i - G_OFF + G_SRC]; else if (i < LR_OFF + 32) v = b[i - LR_OFF + LR_SRC];
          bp[i] = v; } }
    { float* bp = WSP(float, WS_BGU); const float* b = F.in[24];
      for (int i = gt; i < NE * 2048; i += NGT) { const int e = i / 2048, d = i % 2048, pn = d / 256, w = d % 256; const int src = (w < 128) ? pn * 128 + w : 1024 + pn * 128 + (w - 128); bp[i] = b[e * 2048 + src]; } }
    __syncthreads();
    { LAS float* t128 = (LAS float*)F.lds;
      if (F.tid < 128) { float sn, cs; sincospif((float)F.tid * (1.0f / 64.0f), &sn, &cs); t128[2 * F.tid] = cs; t128[2 * F.tid + 1] = sn; }
      __syncthreads();
      bf16* wz = WSP(bf16, WS_WZ); const float* w = F.in[6]; const float rs = 0.08838834764831845f;
      for (int idx = gt; idx < 1024 * 512; idx += NGT) { const int k = idx & 1023, gc = idx >> 10, g = gc >> 7, cp = gc & 127;
          const float* src = w + (size_t)k * IN_W + FN_SRC + g * 128; float ar = 0.f, ai = 0.f;
          for (int c4 = 0; c4 < 32; ++c4) { const f32x4 x = *(const GAS f32x4*)(src + 4 * c4);
#pragma unroll
              for (int j = 0; j < 4; ++j) { const int mm = ((4 * c4 + j) * cp) & 127; const float cs = t128[2 * mm], sn = t128[2 * mm + 1]; ar += x[j] * cs; ai -= x[j] * sn; } }
          wz[(size_t)(gc * 2 + 0) * 1024 + k] = (bf16)f2bf(ar * rs); wz[(size_t)(gc * 2 + 1) * 1024 + k] = (bf16)f2bf(ai * rs); }
      float* bz = WSP(float, WS_BZ); const float* b = F.in[7];
      for (int gc = gt; gc < 512; gc += NGT) { const int g = gc >> 7, cp = gc & 127; float ar = 0.f, ai = 0.f;
          for (int c = 0; c < 128; ++c) { const int mm = (c * cp) & 127; const float cs = t128[2 * mm], sn = t128[2 * mm + 1]; const float x = b[FN_SRC + g * 128 + c]; ar += x * cs; ai -= x * sn; }
          bz[gc * 2] = ar * rs; bz[gc * 2 + 1] = ai * rs; } }
    __syncthreads();
    for (int m = gw; m < T; m += NGW) ln_row(F.in[0] + (size_t)m * D, F.in[2], F.in[3], WSP(float, WS_H) + (size_t)m * D, WSP(bf16, WS_HB) + (size_t)m * D, F.lane, 1.0f);
    for (int m = gw; m < NB * MEM; m += NGW) ln_row(F.in[1] + (size_t)m * D, F.in[4], F.in[5], nullptr, WSP(bf16, WS_MEMN) + (size_t)m * D, F.lane, 1.0f);
}

using pg8::Unit; using pg8::cvt_pk_bf16;
struct EpiBias {
    static constexpr bool PERM = true;
    bf16* O; int ldc; const float* bias;
    __device__ __forceinline__ void operator()(const f32x4 (&acc)[2][2][4][2], const Unit& u, int wr, int wc, int fr, int fq) const {
        const int row0 = u.pm * 256 + wr * 64 + fr, col0 = u.pn * 256 + wc * 32 + 8 * fq;
        f32x4 bv[2][2];
#pragma unroll
        for (int bj = 0; bj < 2; ++bj)
#pragma unroll
            for (int n = 0; n < 2; ++n) bv[bj][n] = bias ? *(const f32x4*)(bias + col0 + bj * 128 + 4 * n) : (f32x4){0.f, 0.f, 0.f, 0.f};
#pragma unroll
        for (int ai = 0; ai < 2; ++ai)
#pragma unroll
            for (int m = 0; m < 4; ++m) { bf16* rowp = O + (size_t)(row0 + ai * 128 + m * 16) * ldc + col0;
#pragma unroll
                for (int bj = 0; bj < 2; ++bj) { const f32x4 v0 = acc[ai][bj][m][0] + bv[bj][0], v1 = acc[ai][bj][m][1] + bv[bj][1];
                    v4u w; w.x = cvt_pk_bf16(v0[0], v0[1]); w.y = cvt_pk_bf16(v0[2], v0[3]); w.z = cvt_pk_bf16(v1[0], v1[1]); w.w = cvt_pk_bf16(v1[2], v1[3]);
                    *(v4u*)(rowp + bj * 128) = w; } }
    }
};
struct EpiZT {
    static constexpr bool PERM = true;
    bf16* O; const float* bias;
    __device__ __forceinline__ void operator()(const f32x4 (&acc)[2][2][4][2], const Unit& u, int wr, int wc, int fr, int fq) const {
        const int row0 = u.pm * 256 + wr * 64 + fr, tok0 = u.pn * 256 + wc * 32 + 8 * fq, b = tok0 >> 12, s0 = tok0 & 4095;
#pragma unroll
        for (int ai = 0; ai < 2; ++ai)
#pragma unroll
            for (int m = 0; m < 4; ++m) { const int row = row0 + ai * 128 + m * 16; const float bz = bias[row]; bf16* rowp = O + ((size_t)b * 1024 + row) * 4096 + s0;
#pragma unroll
                for (int bj = 0; bj < 2; ++bj) { const f32x4 v0 = acc[ai][bj][m][0] + bz, v1 = acc[ai][bj][m][1] + bz;
                    v4u w; w.x = cvt_pk_bf16(v0[0], v0[1]); w.y = cvt_pk_bf16(v0[2], v0[3]); w.z = cvt_pk_bf16(v1[0], v1[1]); w.w = cvt_pk_bf16(v1[2], v1[3]);
                    *(v4u*)(rowp + bj * 128) = w; } }
    }
};
struct EpiFnet {
    static constexpr bool PERM = true;
    bf16* O;
    __device__ __forceinline__ void operator()(const f32x4 (&acc)[2][2][4][2], const Unit& u, int wr, int wc, int fr, int fq) const {
        const int row0 = u.z * 4096 + u.pm * 256 + wr * 64 + fr, col0 = u.pn * 256 + wc * 32 + 8 * fq;
#pragma unroll
        for (int ai = 0; ai < 2; ++ai)
#pragma unroll
            for (int m = 0; m < 4; ++m) { bf16* rowp = O + (size_t)(row0 + ai * 128 + m * 16) * 512 + col0;
#pragma unroll
                for (int bj = 0; bj < 2; ++bj) { const f32x4 v0 = acc[ai][bj][m][0] * 0.015625f, v1 = acc[ai][bj][m][1] * 0.015625f;
                    v4u w; w.x = cvt_pk_bf16(v0[0], v0[1]); w.y = cvt_pk_bf16(v0[2], v0[3]); w.z = cvt_pk_bf16(v1[0], v1[1]); w.w = cvt_pk_bf16(v1[2], v1[3]);
                    *(v4u*)(rowp + bj * 128) = w; } }
    }
};
template <int MODE> struct EpiGate {
    static constexpr bool PERM = true;
    float* MG; bf16* MGB; const bf16* gate;
    __device__ __forceinline__ void operator()(const f32x4 (&acc)[2][2][4][2], const Unit& u, int wr, int wc, int fr, int fq) const {
        const int row0 = u.pm * 256 + wr * 64 + fr, col0 = u.pn * 256 + wc * 32 + 8 * fq;
#pragma unroll
        for (int ai = 0; ai < 2; ++ai)
#pragma unroll
            for (int m = 0; m < 4; ++m) { const size_t row = (size_t)(row0 + ai * 128 + m * 16);
#pragma unroll
                for (int bj = 0; bj < 2; ++bj) { const int col = col0 + bj * 128;
                    const v4u gw = *(const v4u*)(gate + row * NP + col);
                    float gs[8] = {bflo(gw.x), bfhi(gw.x), bflo(gw.y), bfhi(gw.y), bflo(gw.z), bfhi(gw.z), bflo(gw.w), bfhi(gw.w)};
#pragma unroll
                    for (int j = 0; j < 8; ++j) gs[j] = 1.0f / (1.0f + __expf(-gs[j]));
                    f32x4 v0 = acc[ai][bj][m][0] * (f32x4){gs[0], gs[1], gs[2], gs[3]}, v1 = acc[ai][bj][m][1] * (f32x4){gs[4], gs[5], gs[6], gs[7]};
                    float* mp = MG + row * 1024 + col;
                    if (MODE >= 1) { v0 += *(const f32x4*)mp; v1 += *(const f32x4*)(mp + 4); }
                    if (MODE <= 1) { *(f32x4*)mp = v0; *(f32x4*)(mp + 4) = v1; }
                    else { v4u w; w.x = cvt_pk_bf16(v0[0], v0[1]); w.y = cvt_pk_bf16(v0[2], v0[3]); w.z = cvt_pk_bf16(v1[0], v1[1]); w.w = cvt_pk_bf16(v1[2], v1[3]); *(v4u*)(MGB + row * 1024 + col) = w; } } }
    }
};
struct EpiOut {
    static constexpr bool PERM = false;
    float* H; const float* bias;
    __device__ __forceinline__ void operator()(const f32x4 (&acc)[2][2][4][2], const Unit& u, int wr, int wc, int fr, int fq) const {
        const int row0 = u.pm * 256 + wr * 64 + fr, col0 = u.pn * 256 + wc * 32 + 4 * fq;
        f32x4 bv[2][2];
#pragma unroll
        for (int bj = 0; bj < 2; ++bj)
#pragma unroll
            for (int n = 0; n < 2; ++n) bv[bj][n] = *(const f32x4*)(bias + col0 + bj * 128 + n * 16);
#pragma unroll
        for (int ai = 0; ai < 2; ++ai)
#pragma unroll
            for (int m = 0; m < 4; ++m) { float* rowp = H + (size_t)(row0 + ai * 128 + m * 16) * 1024 + col0;
#pragma unroll
                for (int bj = 0; bj < 2; ++bj)
#pragma unroll
                    for (int n = 0; n < 2; ++n) { float* p = rowp + bj * 128 + n * 16; const f32x4 hv = *(const f32x4*)p; *(f32x4*)p = hv * DN_ALPHA + acc[ai][bj][m][n] + bv[bj][n]; } }
    }
};

template <int NPN, bool GATHER_> struct MoeSched {
    static constexpr bool GATHER = GATHER_;
    volatile LAS int* tb;
    const int* list;
    int G, c; int lda, ldb; size_t bstride;
    __device__ __forceinline__ bool next(int i, Unit& u) const {
        const int L = i * G + c, total = tb[64] * NPN; if (L >= total) return false;
        const int tl = L / NPN; int e = 0;
        for (int j = 1; j < 32; ++j) e += (tb[32 + j] <= tl) ? 1 : 0;
        const int te = tb[32 + e + 1] - tb[32 + e], idx = L - tb[32 + e] * NPN;
        u.z = e; u.pm = idx % te; u.pn = idx / te; return true;
    }
    __device__ __forceinline__ size_t a_off(const Unit& u) const { return (size_t)(tb[32 + u.z] + u.pm) * 256 * lda * 2; }
    __device__ __forceinline__ size_t b_off(const Unit& u) const { return (size_t)u.z * bstride + (size_t)u.pn * 256 * ldb * 2; }
    __device__ __forceinline__ unsigned gather_row(const Unit& u, int r) const {
        const int rr = u.pm * 256 + r; int tok = 0; if (rr < tb[u.z]) tok = list[u.z * T + rr] >> 2;
        return (unsigned)tok * (unsigned)(lda * 2);
    }
    __device__ __forceinline__ int row_base(const Unit& u) const { return (tb[32 + u.z] + u.pm) * 256; }
    __device__ __forceinline__ int nvalid(const Unit& u) const { return tb[u.z] - u.pm * 256; }
};
struct EpiSwiglu {
    static constexpr bool PERM = true;
    bf16* ACT; const float* bgu; MoeSched<8, true> S;
    __device__ __forceinline__ void operator()(const f32x4 (&acc)[2][2][4][2], const Unit& u, int wr, int wc, int fr, int fq) const {
        const int rbase = S.row_base(u) + wr * 64 + fr, cw = wc * 32 + 8 * fq;
        const float* bp = bgu + u.z * 2048 + u.pn * 256 + cw;
        const f32x4 bg0 = *(const f32x4*)bp, bg1 = *(const f32x4*)(bp + 4), bu0 = *(const f32x4*)(bp + 128), bu1 = *(const f32x4*)(bp + 132);
#pragma unroll
        for (int ai = 0; ai < 2; ++ai)
#pragma unroll
            for (int m = 0; m < 4; ++m) { const size_t row = (size_t)(rbase + ai * 128 + m * 16);
                float o[8];
#pragma unroll
                for (int n = 0; n < 2; ++n) { const f32x4 gt = acc[ai][0][m][n] + (n ? bg1 : bg0), up = acc[ai][1][m][n] + (n ? bu1 : bu0);
#pragma unroll
                    for (int j = 0; j < 4; ++j) { const float gg = fminf(gt[j], 7.0f), uu = fminf(fmaxf(up[j], -7.0f), 7.0f); o[4 * n + j] = (uu + 1.0f) * gg / (1.0f + __expf(-1.702f * gg)); } }
                v4u w; w.x = cvt_pk_bf16(o[0], o[1]); w.y = cvt_pk_bf16(o[2], o[3]); w.z = cvt_pk_bf16(o[4], o[5]); w.w = cvt_pk_bf16(o[6], o[7]);
                *(v4u*)(ACT + row * 1024 + u.pn * 128 + cw) = w; }
    }
};
struct EpiDown {
    static constexpr bool PERM = true;
    bf16* YB; const float* bd; const float* topw; const int* list; MoeSched<4, false> S;
    __device__ __forceinline__ void operator()(const f32x4 (&acc)[2][2][4][2], const Unit& u, int wr, int wc, int fr, int fq) const {
        const int nv = S.nvalid(u), col0 = u.pn * 256 + wc * 32 + 8 * fq;
        const float* bp = bd + u.z * 1024 + col0;
        f32x4 bv[2][2];
#pragma unroll
        for (int bj = 0; bj < 2; ++bj)
#pragma unroll
            for (int n = 0; n < 2; ++n) bv[bj][n] = *(const f32x4*)(bp + bj * 128 + 4 * n);
#pragma unroll
        for (int ai = 0; ai < 2; ++ai)
#pragma unroll
            for (int m = 0; m < 4; ++m) { const int r = ai * 128 + wr * 64 + m * 16 + fr;
                if (r < nv) { const int a = list[u.z * T + u.pm * 256 + r]; const float w = topw[a]; bf16* rowp = YB + (size_t)a * 1024 + col0;
#pragma unroll
                    for (int bj = 0; bj < 2; ++bj) { const f32x4 v0 = (acc[ai][bj][m][0] + bv[bj][0]) * w, v1 = (acc[ai][bj][m][1] + bv[bj][1]) * w;
                        v4u o; o.x = cvt_pk_bf16(v0[0], v0[1]); o.y = cvt_pk_bf16(v0[2], v0[3]); o.z = cvt_pk_bf16(v1[0], v1[1]); o.w = cvt_pk_bf16(v1[2], v1[3]);
                        *(v4u*)(rowp + bj * 128) = o; } } }
    }
};

typedef float f32x16 __attribute__((ext_vector_type(16)));
typedef float f32x2v __attribute__((ext_vector_type(2)));
typedef __bf16 bf16v2 __attribute__((ext_vector_type(2)));
__device__ __forceinline__ unsigned pkc(float lo, float hi) { return __builtin_bit_cast(unsigned, __builtin_convertvector((f32x2v){lo, hi}, bf16v2)); }
#define MFMA32(a, b, c) __builtin_amdgcn_mfma_f32_32x32x16_bf16((a), (b), (c), 0, 0, 0)
constexpr int G1_P = 272, G1_QF = 0, G1_KF = 17408, G1_QB = 34816, G1_KB = 52224, G1_VT = 69632, G1_VP = 144, G1_ATT = 106496, G1_LR = 115712, G1_TOT = 123904;
static_assert(G1_TOT + 8192 <= LDSCTL_OFF, "G1 LDS map");
__device__ __forceinline__ float logsig16(float z) { return (fminf(z, 0.f) - log1pf(__expf(-fabsf(z)))) * 0.0625f; }
__device__ __forceinline__ void gla_g1(Frame& F) {
    const bf16* proj = WSP(bf16, WS_PROJ);
    LAS unsigned char* L = F.lds;
    const int wave = F.wave;
    for (int unit = F.vcu; unit < 1024; unit += F.G) {
        int tid = F.tid; asm volatile("" : "+v"(tid));
        const int lane = tid & 63, l31 = lane & 31, hh = lane >> 5;
        const int n = unit & 63, bh = unit >> 6, h = bh & 3, b = bh >> 2;
        const size_t t0 = (size_t)b * SEQ + n * 64;
        __syncthreads();
        { const int row = tid >> 3, c4 = (tid & 7) * 4; const v2u w = *(const GAS v2u*)(proj + (t0 + row) * NP + LR_OFF + c4);
          LAS float* p = (LAS float*)(L + G1_LR) + row * 32 + c4; p[0] = bflo(w.x); p[1] = bfhi(w.x); p[2] = bflo(w.y); p[3] = bfhi(w.y); }
        { const int dvp = tid & 127, tg = tid >> 7; unsigned lo[8], hi[8];
#pragma unroll
          for (int t2 = 0; t2 < 8; ++t2) { const unsigned w0 = *(const GAS unsigned*)(proj + (t0 + 16 * tg + 2 * t2) * NP + V_OFF + h * 256 + 2 * dvp), w1 = *(const GAS unsigned*)(proj + (t0 + 16 * tg + 2 * t2 + 1) * NP + V_OFF + h * 256 + 2 * dvp);
              lo[t2] = (w0 & 0xffffu) | (w1 << 16); hi[t2] = (w0 >> 16) | (w1 & 0xffff0000u); }
          LAS unsigned char* p0 = L + G1_VT + (2 * dvp) * G1_VP + 32 * tg;
          *(LAS v4u*)p0 = (v4u){lo[0], lo[1], lo[2], lo[3]}; *(LAS v4u*)(p0 + 16) = (v4u){lo[4], lo[5], lo[6], lo[7]};
          *(LAS v4u*)(p0 + G1_VP) = (v4u){hi[0], hi[1], hi[2], hi[3]}; *(LAS v4u*)(p0 + G1_VP + 16) = (v4u){hi[4], hi[5], hi[6], hi[7]};
          bf16* vg = WSP(bf16, WS_VT) + ((size_t)bh * 64 + n) * 16384 + (2 * dvp) * 64 + 16 * tg;
          *(GAS v4u*)vg = (v4u){lo[0], lo[1], lo[2], lo[3]}; *(GAS v4u*)(vg + 8) = (v4u){lo[4], lo[5], lo[6], lo[7]};
          *(GAS v4u*)(vg + 64) = (v4u){hi[0], hi[1], hi[2], hi[3]}; *(GAS v4u*)(vg + 72) = (v4u){hi[4], hi[5], hi[6], hi[7]}; }
        __syncthreads();
        const int jp = tid & 63, ig = tid >> 6;
        float cf[8][2], cb[8][2];
#pragma unroll
        for (int dir = 0; dir < 2; ++dir) { const float* Wd = (dir ? F.in[10] : F.in[8]) + h * 128 + 2 * jp; const float* bd = (dir ? F.in[11] : F.in[9]) + h * 128 + 2 * jp;
            float w0[16], w1[16];
#pragma unroll
            for (int r = 0; r < 16; ++r) { const f32x2v w = *(const GAS f32x2v*)(Wd + r * 512); w0[r] = w.x; w1[r] = w.y; }
            const f32x2v bb = *(const GAS f32x2v*)bd;
#pragma unroll
            for (int rr = 0; rr < 8; ++rr) { const LAS f32x4* lr4 = (const LAS f32x4*)((LAS float*)(L + G1_LR) + (8 * ig + rr) * 32 + dir * 16); float z0 = bb.x, z1 = bb.y;
#pragma unroll
                for (int r4 = 0; r4 < 4; ++r4) { const f32x4 x = lr4[r4];
#pragma unroll
                    for (int j = 0; j < 4; ++j) { z0 += x[j] * w0[4 * r4 + j]; z1 += x[j] * w1[4 * r4 + j]; } }
                if (dir == 0) { cf[rr][0] = logsig16(z0); cf[rr][1] = logsig16(z1); } else { cb[rr][0] = logsig16(z0); cb[rr][1] = logsig16(z1); } }
        }
#pragma unroll
        for (int rr = 1; rr < 8; ++rr) { cf[rr][0] += cf[rr - 1][0]; cf[rr][1] += cf[rr - 1][1]; }
#pragma unroll
        for (int rr = 6; rr >= 0; --rr) { cb[rr][0] += cb[rr + 1][0]; cb[rr][1] += cb[rr + 1][1]; }
        { LAS float* tot = (LAS float*)(L + G1_TOT);
          *(LAS f32x2v*)(tot + (ig * 2 + 0) * 128 + 2 * jp) = (f32x2v){cf[7][0], cf[7][1]}; *(LAS f32x2v*)(tot + (ig * 2 + 1) * 128 + 2 * jp) = (f32x2v){cb[0][0], cb[0][1]}; }
        __syncthreads();
        float offf0 = 0.f, offf1 = 0.f, offb0 = 0.f, offb1 = 0.f, blf0 = 0.f, blf1 = 0.f, bb00 = 0.f, bb01 = 0.f;
        { const LAS float* tot = (const LAS float*)(L + G1_TOT);
#pragma unroll
          for (int g = 0; g < 8; ++g) { const f32x2v tf = *(const LAS f32x2v*)(tot + (g * 2 + 0) * 128 + 2 * jp), tb = *(const LAS f32x2v*)(tot + (g * 2 + 1) * 128 + 2 * jp);
              blf0 += tf.x; blf1 += tf.y; bb00 += tb.x; bb01 += tb.y;
              if (g < ig) { offf0 += tf.x; offf1 += tf.y; } if (g > ig) { offb0 += tb.x; offb1 += tb.y; } } }
        { const int blkf = ((bh * 2 + 0) * 64 + n), blkb = ((bh * 2 + 1) * 64 + n);
          bf16* qinf = WSP(bf16, WS_QIN) + (size_t)blkf * 8192; bf16* qinb = WSP(bf16, WS_QIN) + (size_t)blkb * 8192;
          float ksf0[8], ksf1[8], ksb0[8], ksb1[8];
#pragma unroll
          for (int rr = 0; rr < 8; ++rr) { const int row = 8 * ig + rr;
              const unsigned qw = *(const GAS unsigned*)(proj + (t0 + row) * NP + Q_OFF + h * 128 + 2 * jp), kw = *(const GAS unsigned*)(proj + (t0 + row) * NP + K_OFF + h * 128 + 2 * jp);
              const float q0 = bflo(qw) * 0.08838834764831845f, q1 = bfhi(qw) * 0.08838834764831845f, k0 = bflo(kw), k1 = bfhi(kw);
              const float f0 = cf[rr][0] + offf0, f1 = cf[rr][1] + offf1, g0 = cb[rr][0] + offb0, g1 = cb[rr][1] + offb1;
              const unsigned qf = pkc(q0 * __expf(f0), q1 * __expf(f1)), kf = pkc(k0 * __expf(-f0), k1 * __expf(-f1));
              const unsigned qb = pkc(q0 * __expf(g0), q1 * __expf(g1)), kb = pkc(k0 * __expf(-g0), k1 * __expf(-g1));
              *(LAS unsigned*)(L + G1_QF + row * G1_P + 4 * jp) = qf; *(LAS unsigned*)(L + G1_KF + row * G1_P + 4 * jp) = kf;
              *(LAS unsigned*)(L + G1_QB + row * G1_P + 4 * jp) = qb; *(LAS unsigned*)(L + G1_KB + row * G1_P + 4 * jp) = kb;
              *(GAS unsigned*)(qinf + row * 128 + 2 * jp) = qf; *(GAS unsigned*)(qinb + row * 128 + 2 * jp) = qb;
              ksf0[rr] = k0 * __expf(blf0 - f0); ksf1[rr] = k1 * __expf(blf1 - f1); ksb0[rr] = k0 * __expf(bb00 - g0); ksb1[rr] = k1 * __expf(bb01 - g1); }
          bf16* kstf = WSP(bf16, WS_KST) + (size_t)blkf * 8192 + (2 * jp) * 64 + 8 * ig; bf16* kstb = WSP(bf16, WS_KST) + (size_t)blkb * 8192 + (2 * jp) * 64 + 8 * ig;
          *(GAS v4u*)kstf = (v4u){pkc(ksf0[0], ksf0[1]), pkc(ksf0[2], ksf0[3]), pkc(ksf0[4], ksf0[5]), pkc(ksf0[6], ksf0[7])};
          *(GAS v4u*)(kstf + 64) = (v4u){pkc(ksf1[0], ksf1[1]), pkc(ksf1[2], ksf1[3]), pkc(ksf1[4], ksf1[5]), pkc(ksf1[6], ksf1[7])};
          *(GAS v4u*)kstb = (v4u){pkc(ksb0[0], ksb0[1]), pkc(ksb0[2], ksb0[3]), pkc(ksb0[4], ksb0[5]), pkc(ksb0[6], ksb0[7])};
          *(GAS v4u*)(kstb + 64) = (v4u){pkc(ksb1[0], ksb1[1]), pkc(ksb1[2], ksb1[3]), pkc(ksb1[4], ksb1[5]), pkc(ksb1[6], ksb1[7])};
          if (ig == 0) { float* dd = WSP(float, WS_DD); *(GAS f32x2v*)(dd + (size_t)blkf * 128 + 2 * jp) = (f32x2v){__expf(blf0), __expf(blf1)}; *(GAS f32x2v*)(dd + (size_t)blkb * 128 + 2 * jp) = (f32x2v){__expf(bb00), __expf(bb01)}; } }
        __syncthreads();
        if (wave < 4) { const int jt = (wave == 1 || wave == 3) ? 1 : 0, it = (wave == 1 || wave == 2) ? 1 : 0; const bool dof = (wave != 3), dob = (wave != 2);
            f32x16 xf, xb;
#pragma unroll
            for (int r = 0; r < 16; ++r) { xf[r] = 0.f; xb[r] = 0.f; }
            const int ao = (32 * jt + l31) * G1_P + 16 * hh, bo = (32 * it + l31) * G1_P + 16 * hh;
            if (dof) {
#pragma unroll
                for (int ks = 0; ks < 8; ++ks) xf = MFMA32(*(const LAS bf16x8*)(L + G1_KF + ao + 32 * ks), *(const LAS bf16x8*)(L + G1_QF + bo + 32 * ks), xf); }
            if (dob) {
#pragma unroll
                for (int ks = 0; ks < 8; ++ks) xb = MFMA32(*(const LAS bf16x8*)(L + G1_KB + ao + 32 * ks), *(const LAS bf16x8*)(L + G1_QB + bo + 32 * ks), xb); }
            const int i = 32 * it + l31;
#pragma unroll
            for (int g = 0; g < 4; ++g) { float vv[4];
#pragma unroll
                for (int e = 0; e < 4; ++e) { const int jq = 32 * jt + 8 * g + 4 * hh + e; vv[e] = ((dof && jq <= i) ? xf[4 * g + e] : 0.f) + ((dob && jq >= i) ? xb[4 * g + e] : 0.f); }
                *(LAS v2u*)(L + G1_ATT + i * G1_VP + (32 * jt + 8 * g + 4 * hh) * 2) = (v2u){pkc(vv[0], vv[1]), pkc(vv[2], vv[3])}; } }
        __syncthreads();
        { bf16* oi = WSP(bf16, WS_OI);
#pragma unroll
          for (int it = 0; it < 2; ++it) { f32x16 acc;
#pragma unroll
              for (int r = 0; r < 16; ++r) acc[r] = 0.f;
#pragma unroll
              for (int ks = 0; ks < 4; ++ks) acc = MFMA32(*(const LAS bf16x8*)(L + G1_ATT + (32 * it + l31) * G1_VP + 32 * ks + 16 * hh), *(const LAS bf16x8*)(L + G1_VT + (32 * wave + l31) * G1_VP + 32 * ks + 16 * hh), acc);
#pragma unroll
              for (int r = 0; r < 16; ++r) { const int i = 32 * it + (r & 3) + 8 * (r >> 2) + 4 * hh; oi[(t0 + i) * 1024 + h * 256 + 32 * wave + l31] = (bf16)f2bf(acc[r]); } } }
    }
    __syncthreads();
}
constexpr int G2_QIN = 0, G2_KST = 17408, G2_VT = 35840, G2_D = 54272, G2_BUF = 54784;
__device__ __forceinline__ void gla_g2(Frame& F, int wg) {
    const int half = wg & 1, bhd = wg >> 1, dir = bhd & 1, bh = bhd >> 1, h = bh & 3, b = bh >> 2;
    LAS unsigned char* L = F.lds;
    const int tid = F.tid, lane = F.lane, wave = F.wave, l31 = lane & 31, hh = lane >> 5;
    const bf16* qin = WSP(bf16, WS_QIN) + (size_t)(bhd * 64) * 8192; const bf16* kst = WSP(bf16, WS_KST) + (size_t)(bhd * 64) * 8192;
    const bf16* vt = WSP(bf16, WS_VT) + (size_t)(bh * 64) * 16384 + half * 8192; const float* dd = WSP(float, WS_DD) + (size_t)(bhd * 64) * 128;
    bf16* og = dir ? WSP(bf16, WS_OB) : WSP(bf16, WS_OF);
    v4u st[6]; v4u std_;
    const int p0 = tid, p1 = tid + 512;
    const int lq0 = G2_QIN + (p0 >> 4) * 272 + (p0 & 15) * 16, lq1 = G2_QIN + (p1 >> 4) * 272 + (p1 & 15) * 16;
    const int lk0 = (p0 >> 3) * 144 + (p0 & 7) * 16, lk1 = (p1 >> 3) * 144 + (p1 & 7) * 16;
#define G2_LOAD(c) do { const GAS v4u* q4 = (const GAS v4u*)(qin + (size_t)(c) * 8192); const GAS v4u* k4 = (const GAS v4u*)(kst + (size_t)(c) * 8192); const GAS v4u* v4 = (const GAS v4u*)(vt + (size_t)(c) * 16384); \
        st[0] = q4[p0]; st[1] = q4[p1]; st[2] = k4[p0]; st[3] = k4[p1]; st[4] = v4[p0]; st[5] = v4[p1]; if (tid < 32) std_ = ((const GAS v4u*)(dd + (size_t)(c) * 128))[tid]; } while (0)
#define G2_STORE(bufo) do { LAS unsigned char* B_ = L + (bufo); *(LAS v4u*)(B_ + lq0) = st[0]; *(LAS v4u*)(B_ + lq1) = st[1]; *(LAS v4u*)(B_ + G2_KST + lk0) = st[2]; *(LAS v4u*)(B_ + G2_KST + lk1) = st[3]; \
        *(LAS v4u*)(B_ + G2_VT + lk0) = st[4]; *(LAS v4u*)(B_ + G2_VT + lk1) = st[5]; if (tid < 32) *(LAS v4u*)(B_ + G2_D + 16 * tid) = std_; } while (0)
    f32x16 S0, S1, S2, S3;
#pragma unroll
    for (int r = 0; r < 16; ++r) { S0[r] = 0.f; S1[r] = 0.f; S2[r] = 0.f; S3[r] = 0.f; }
    bf16x8 Sb[4][2];
#pragma unroll
    for (int t = 0; t < 4; ++t)
#pragma unroll
        for (int s2 = 0; s2 < 2; ++s2) Sb[t][s2] = (bf16x8){0, 0, 0, 0, 0, 0, 0, 0};
    __syncthreads();
    { const int c0 = dir ? 63 : 0; G2_LOAD(c0); G2_STORE(0); }
    __syncthreads();
    for (int nn = 0; nn < 64; ++nn) {
        const int c = dir ? 63 - nn : nn; const int bufo = (nn & 1) * G2_BUF;
        if (nn + 1 < 64) { const int cn = dir ? 62 - nn : nn + 1; G2_LOAD(cn); }
        if (wave < 4) {
            const LAS unsigned char* B = L + bufo;
#pragma unroll
            for (int it = 0; it < 2; ++it) { f32x16 oacc;
#pragma unroll
                for (int r = 0; r < 16; ++r) oacc[r] = 0.f;
#pragma unroll
                for (int t = 0; t < 4; ++t)
#pragma unroll
                    for (int s2 = 0; s2 < 2; ++s2) { const LAS unsigned char* ap = B + G2_QIN + (32 * it + l31) * 272 + (32 * t + 16 * s2 + 4 * hh) * 2;
                        const v2u a_lo = *(const LAS v2u*)ap, a_hi = *(const LAS v2u*)(ap + 16);
                        const bf16x8 af = __builtin_bit_cast(bf16x8, (v4u){a_lo.x, a_lo.y, a_hi.x, a_hi.y});
                        oacc = MFMA32(af, Sb[t][s2], oacc); }
                const size_t tb = (size_t)b * SEQ + c * 64;
#pragma unroll
                for (int r = 0; r < 16; ++r) { const int i = 32 * it + (r & 3) + 8 * (r >> 2) + 4 * hh; og[(tb + i) * 1024 + h * 256 + half * 128 + 32 * wave + l31] = (bf16)f2bf(oacc[r]); } }
#define G2_UPD(SX, t) do { _Pragma("unroll") for (int g = 0; g < 4; ++g) { const f32x4 d4 = *(const LAS f32x4*)(B + G2_D + (32 * (t) + 8 * g + 4 * hh) * 4); \
                SX[4 * g] *= d4[0]; SX[4 * g + 1] *= d4[1]; SX[4 * g + 2] *= d4[2]; SX[4 * g + 3] *= d4[3]; } \
            _Pragma("unroll") for (int ks = 0; ks < 4; ++ks) SX = MFMA32(*(const LAS bf16x8*)(B + G2_KST + (32 * (t) + l31) * 144 + 32 * ks + 16 * hh), *(const LAS bf16x8*)(B + G2_VT + (32 * wave + l31) * 144 + 32 * ks + 16 * hh), SX); \
            _Pragma("unroll") for (int s2 = 0; s2 < 2; ++s2) Sb[t][s2] = __builtin_bit_cast(bf16x8, (v4u){pkc(SX[8 * s2], SX[8 * s2 + 1]), pkc(SX[8 * s2 + 2], SX[8 * s2 + 3]), pkc(SX[8 * s2 + 4], SX[8 * s2 + 5]), pkc(SX[8 * s2 + 6], SX[8 * s2 + 7])}); } while (0)
            G2_UPD(S0, 0); G2_UPD(S1, 1); G2_UPD(S2, 2); G2_UPD(S3, 3);
#undef G2_UPD
        }
        if (nn + 1 < 64) G2_STORE(((nn + 1) & 1) * G2_BUF);
        __syncthreads();
    }
#undef G2_LOAD
#undef G2_STORE
}

__device__ __forceinline__ void gla_finalize(Frame& F) {
    const int gw = F.vcu * NWAVES + F.wave, NGW = F.G * NWAVES;
    const bf16* oi = WSP(bf16, WS_OI); const bf16* of = WSP(bf16, WS_OF); const bf16* ob = WSP(bf16, WS_OB); const bf16* proj = WSP(bf16, WS_PROJ); bf16* og = WSP(bf16, WS_OG);
    const f32x4 gg = ((const GAS f32x4*)F.in[12])[F.lane];
    for (int t = gw; t < T; t += NGW) {
#pragma unroll
        for (int j = 0; j < 4; ++j) { const size_t o = (size_t)t * 1024 + 256 * j + 4 * F.lane;
            const v2u a = *(const GAS v2u*)(oi + o), bq = *(const GAS v2u*)(of + o), c = *(const GAS v2u*)(ob + o);
            f32x4 v = (f32x4){bflo(a.x) + bflo(bq.x) + bflo(c.x), bfhi(a.x) + bfhi(bq.x) + bfhi(c.x), bflo(a.y) + bflo(bq.y) + bflo(c.y), bfhi(a.y) + bfhi(bq.y) + bfhi(c.y)};
            const float ms = wave_sum((v.x * v.x + v.y * v.y) + (v.z * v.z + v.w * v.w)) * (1.0f / 256.0f); const float rs = 1.0f / sqrtf(ms + RMS_EPS);
            const v2u rw = *(const GAS v2u*)(proj + (size_t)t * NP + R_OFF + 256 * j + 4 * F.lane);
            const float r0 = bflo(rw.x), r1 = bfhi(rw.x), r2 = bflo(rw.y), r3 = bfhi(rw.y);
            v = v * rs * gg;
            v.x *= r0 / (1.0f + __expf(-r0)); v.y *= r1 / (1.0f + __expf(-r1)); v.z *= r2 / (1.0f + __expf(-r2)); v.w *= r3 / (1.0f + __expf(-r3));
            *(GAS v2u*)(og + o) = (v2u){pk2(v.x, v.y), pk2(v.z, v.w)}; }
    }
}

constexpr int XA_KP = 272, XA_VP = 528;
__device__ __forceinline__ void xattn_mfma(Frame& F) {
    const bf16* proj = WSP(bf16, WS_PROJ); const bf16* kg = WSP(bf16, WS_KV); const bf16* vtg = kg + 1024 * 512; bf16* om = WSP(bf16, WS_OM);
    LAS unsigned char* L = F.lds; const int wave = F.wave;
    for (int unit = F.vcu; unit < 256; unit += F.G) {
        int tid = F.tid; asm volatile("" : "+v"(tid));
        const int lane = tid & 63, l31 = lane & 31, hh = lane >> 5;
        const int qt = unit & 15, bh = unit >> 4, h = bh & 3, b = bh >> 2;
        const size_t t0 = (size_t)b * SEQ + qt * 256 + 32 * wave;
        __syncthreads();
#pragma unroll
        for (int j = 0; j < 8; ++j) { const int p = tid + 512 * j, row = p >> 4, pc = p & 15; *(LAS v4u*)(L + row * XA_KP + pc * 16) = *(const GAS v4u*)(kg + (size_t)(b * 256 + row) * 512 + h * 128 + pc * 8); }
        bf16x8 qf[8];
#pragma unroll
        for (int ks = 0; ks < 8; ++ks) qf[ks] = *(const GAS bf16x8*)(proj + (t0 + l31) * NP + MQ_OFF + h * 128 + 16 * ks + 8 * hh);
        __syncthreads();
        f32x16 X[8];
#pragma unroll
        for (int kt = 0; kt < 8; ++kt) {
#pragma unroll
            for (int r = 0; r < 16; ++r) X[kt][r] = 0.f;
#pragma unroll
            for (int ks = 0; ks < 8; ++ks) X[kt] = MFMA32(*(const LAS bf16x8*)(L + (32 * kt + l31) * XA_KP + 32 * ks + 16 * hh), qf[ks], X[kt]); }
        float mx = -3.0e38f;
#pragma unroll
        for (int kt = 0; kt < 8; ++kt)
#pragma unroll
            for (int r = 0; r < 16; ++r) mx = fmaxf(mx, X[kt][r]);
        mx = fmaxf(mx, __shfl_xor(mx, 32));
        float sm = 0.f;
#pragma unroll
        for (int kt = 0; kt < 8; ++kt)
#pragma unroll
            for (int r = 0; r < 16; ++r) { X[kt][r] = __expf((X[kt][r] - mx) * 0.08838834764831845f); sm += X[kt][r]; }
        sm += __shfl_xor(sm, 32);
        const float inv = 1.0f / sm;
        bf16x8 P[8][2];
#pragma unroll
        for (int kt = 0; kt < 8; ++kt)
#pragma unroll
            for (int s2 = 0; s2 < 2; ++s2) P[kt][s2] = __builtin_bit_cast(bf16x8, (v4u){pkc(X[kt][8 * s2] * inv, X[kt][8 * s2 + 1] * inv), pkc(X[kt][8 * s2 + 2] * inv, X[kt][8 * s2 + 3] * inv), pkc(X[kt][8 * s2 + 4] * inv, X[kt][8 * s2 + 5] * inv), pkc(X[kt][8 * s2 + 6] * inv, X[kt][8 * s2 + 7] * inv)});
        __syncthreads();
#pragma unroll
        for (int j = 0; j < 8; ++j) { const int p = tid + 512 * j, d = p >> 5, pc = p & 31; *(LAS v4u*)(L + d * XA_VP + pc * 16) = *(const GAS v4u*)(vtg + (size_t)(h * 128 + d) * 1024 + b * 256 + pc * 8); }
        __syncthreads();
#pragma unroll
        for (int dt = 0; dt < 4; ++dt) { f32x16 o;
#pragma unroll
            for (int r = 0; r < 16; ++r) o[r] = 0.f;
#pragma unroll
            for (int kt = 0; kt < 8; ++kt)
#pragma unroll
                for (int s2 = 0; s2 < 2; ++s2) { const LAS unsigned char* bp = L + (32 * dt + l31) * XA_VP + (32 * kt + 16 * s2 + 4 * hh) * 2;
                    const v2u b_lo = *(const LAS v2u*)bp, b_hi = *(const LAS v2u*)(bp + 16);
                    o = MFMA32(P[kt][s2], __builtin_bit_cast(bf16x8, (v4u){b_lo.x, b_lo.y, b_hi.x, b_hi.y}), o); }
#pragma unroll
            for (int r = 0; r < 16; ++r) { const int i = (r & 3) + 8 * (r >> 2) + 4 * hh; om[(t0 + i) * 512 + h * 128 + 32 * dt + l31] = (bf16)f2bf(o[r]); } }
    }
    __syncthreads();
}

constexpr int FN_F1 = 0, FN_F2 = 34816, FN_OT = 52224;
__device__ __forceinline__ void fnet_fft(Frame& F) {
    LAS unsigned char* L = F.lds; const int wave = F.wave;
    const bf16* zt = WSP(bf16, WS_ZT); bf16* fo = WSP(bf16, WS_F);
    __syncthreads();
    for (int i = F.tid; i < 128 * 128; i += 512) { const int j = i >> 7, k = i & 127, pp = j >> 6, ap = j & 63, p = k >> 6, a = k & 63; const float t = (float)((a * ap) & 63) * (1.0f / 64.0f);
        const float cs = __builtin_amdgcn_cosf(t), sn = __builtin_amdgcn_sinf(t); const float v = (pp == p) ? cs : (pp == 0 ? sn : -sn);
        *(LAS bf16*)(L + FN_F1 + j * 272 + k * 2) = (bf16)f2bf(v); }
    for (int i = F.tid; i < 64 * 128; i += 512) { const int cp = i >> 7, k = i & 127, p = k >> 6, c = k & 63; const float t = (float)((c * cp) & 63) * (1.0f / 64.0f);
        const float v = p ? __builtin_amdgcn_sinf(t) : __builtin_amdgcn_cosf(t);
        *(LAS bf16*)(L + FN_F2 + cp * 272 + k * 2) = (bf16)f2bf(v); }
    __syncthreads();
    for (int unit = F.vcu; unit < 256; unit += F.G) {
        int tid = F.tid; asm volatile("" : "+v"(tid));
        const int lane = tid & 63, l31 = lane & 31, hh = lane >> 5;
        const int b = unit >> 6, ch0 = (unit & 63) * 8, ch = ch0 + wave;
        const bf16* zr = zt + ((size_t)(b * 512 + ch) * 2) * 4096;
        f32x16 D00, D01, D02, D03, D10, D11, D12, D13;
#pragma unroll
        for (int r = 0; r < 16; ++r) { D00[r] = 0.f; D01[r] = 0.f; D02[r] = 0.f; D03[r] = 0.f; D10[r] = 0.f; D11[r] = 0.f; D12[r] = 0.f; D13[r] = 0.f; }
#pragma unroll 2
        for (int ks = 0; ks < 8; ++ks) { const bf16* zp = zr + (ks >> 2) * 4096 + (size_t)(16 * (ks & 3) + 8 * hh) * 64 + l31;
            unsigned short g0[8], g1[8];
#pragma unroll
            for (int e = 0; e < 8; ++e) { g0[e] = *(const GAS unsigned short*)(zp + e * 64); g1[e] = *(const GAS unsigned short*)(zp + e * 64 + 32); }
            const bf16x8 a0 = __builtin_bit_cast(bf16x8, (v4u){(unsigned)g0[0] | ((unsigned)g0[1] << 16), (unsigned)g0[2] | ((unsigned)g0[3] << 16), (unsigned)g0[4] | ((unsigned)g0[5] << 16), (unsigned)g0[6] | ((unsigned)g0[7] << 16)});
            const bf16x8 a1 = __builtin_bit_cast(bf16x8, (v4u){(unsigned)g1[0] | ((unsigned)g1[1] << 16), (unsigned)g1[2] | ((unsigned)g1[3] << 16), (unsigned)g1[4] | ((unsigned)g1[5] << 16), (unsigned)g1[6] | ((unsigned)g1[7] << 16)});
            const LAS unsigned char* bp = L + FN_F1 + l31 * 272 + (16 * ks + 8 * hh) * 2;
            const bf16x8 b0 = *(const LAS bf16x8*)bp, b1 = *(const LAS bf16x8*)(bp + 32 * 272), b2 = *(const LAS bf16x8*)(bp + 64 * 272), b3 = *(const LAS bf16x8*)(bp + 96 * 272);
            D00 = MFMA32(a0, b0, D00); D01 = MFMA32(a0, b1, D01); D02 = MFMA32(a0, b2, D02); D03 = MFMA32(a0, b3, D03);
            D10 = MFMA32(a1, b0, D10); D11 = MFMA32(a1, b1, D11); D12 = MFMA32(a1, b2, D12); D13 = MFMA32(a1, b3, D13); }
#define FN_TW(YR, YI, ct, at) do { _Pragma("unroll") for (int r = 0; r < 16; ++r) { const int c_ = 32 * (ct) + (r & 3) + 8 * (r >> 2) + 4 * hh, ap_ = 32 * (at) + l31; const float t_ = (float)(c_ * ap_) * (1.0f / 4096.0f); \
            const float cs_ = __builtin_amdgcn_cosf(t_), sn_ = __builtin_amdgcn_sinf(t_), yr_ = YR[r], yi_ = YI[r]; YR[r] = yr_ * cs_ + yi_ * sn_; YI[r] = yi_ * cs_ - yr_ * sn_; } } while (0)
        FN_TW(D00, D02, 0, 0); FN_TW(D01, D03, 0, 1); FN_TW(D10, D12, 1, 0); FN_TW(D11, D13, 1, 1);
#undef FN_TW
#define FN_PK(X, s2) __builtin_bit_cast(bf16x8, (v4u){pkc(X[8 * (s2)], X[8 * (s2) + 1]), pkc(X[8 * (s2) + 2], X[8 * (s2) + 3]), pkc(X[8 * (s2) + 4], X[8 * (s2) + 5]), pkc(X[8 * (s2) + 6], X[8 * (s2) + 7])})
#define FN_A(mt, p, ct, s2) ({ const LAS unsigned char* ap_ = L + FN_F2 + (32 * (mt) + l31) * 272 + (64 * (p) + 32 * (ct) + 16 * (s2) + 4 * hh) * 2; const v2u lo_ = *(const LAS v2u*)ap_, hi_ = *(const LAS v2u*)(ap_ + 16); __builtin_bit_cast(bf16x8, (v4u){lo_.x, lo_.y, hi_.x, hi_.y}); })
#define FN_S2(at, YR0, YI0, YR1, YI1) do { \
            const bf16x8 r00 = FN_PK(YR0, 0), r01 = FN_PK(YR0, 1), r10 = FN_PK(YR1, 0), r11 = FN_PK(YR1, 1), i00 = FN_PK(YI0, 0), i01 = FN_PK(YI0, 1), i10 = FN_PK(YI1, 0), i11 = FN_PK(YI1, 1); \
            _Pragma("unroll") for (int mt = 0; mt < 2; ++mt) { f32x16 acc; _Pragma("unroll") for (int r = 0; r < 16; ++r) acc[r] = 0.f; \
                acc = MFMA32(FN_A(mt, 0, 0, 0), r00, acc); acc = MFMA32(FN_A(mt, 0, 0, 1), r01, acc); acc = MFMA32(FN_A(mt, 0, 1, 0), r10, acc); acc = MFMA32(FN_A(mt, 0, 1, 1), r11, acc); \
                acc = MFMA32(FN_A(mt, 1, 0, 0), i00, acc); acc = MFMA32(FN_A(mt, 1, 0, 1), i01, acc); acc = MFMA32(FN_A(mt, 1, 1, 0), i10, acc); acc = MFMA32(FN_A(mt, 1, 1, 1), i11, acc); \
                _Pragma("unroll") for (int r = 0; r < 16; ++r) { const int cp_ = 32 * mt + (r & 3) + 8 * (r >> 2) + 4 * hh, sp_ = 32 * (at) + l31 + 64 * cp_; *(LAS bf16*)(L + FN_OT + sp_ * 16 + wave * 2) = (bf16)f2bf(acc[r] * 0.015625f); } } } while (0)
        FN_S2(0, D00, D02, D10, D12); FN_S2(1, D01, D03, D11, D13);
#undef FN_S2
#undef FN_A
#undef FN_PK
        __syncthreads();
#pragma unroll
        for (int j = 0; j < 8; ++j) { const int sp = tid + 512 * j; *(GAS v4u*)(fo + ((size_t)(b * 4096 + sp)) * 512 + ch0) = *(const LAS v4u*)(L + FN_OT + sp * 16); }
        __syncthreads();
    }
}

__device__ __forceinline__ void router_phase(Frame& F) {
    LAS int* hist = (LAS int*)(F.lds);
    const bf16* h1b = WSP(bf16, WS_HB); const bf16* wrt = WSP(bf16, WS_WRT); const float* brt = F.in[22];
    int* list = WSP(int, WS_RT); float* topw = WSP(float, WS_TOPW); unsigned* cnt = (unsigned*)(F.ws + WS_CTL) + CW_CNT;
    const int tq = F.lane & 15, q = F.lane >> 4;
    for (int it = F.vcu; it < T / 128; it += F.G) {
        if (F.tid < 64) hist[F.tid] = 0;
        __syncthreads();
        const int tok = it * 128 + F.wave * 16 + tq;
        f32x4 a0 = {0.f, 0.f, 0.f, 0.f}, a1 = {0.f, 0.f, 0.f, 0.f};
        const bf16* ap0 = wrt + (size_t)tq * 1024 + 8 * q; const bf16* ap1 = wrt + (size_t)(16 + tq) * 1024 + 8 * q; const bf16* bp = h1b + (size_t)tok * 1024 + 8 * q;
#pragma unroll 4
        for (int ks = 0; ks < 32; ++ks) { const bf16x8 bf = *(const GAS bf16x8*)(bp + 32 * ks);
            a0 = __builtin_amdgcn_mfma_f32_16x16x32_bf16(*(const GAS bf16x8*)(ap0 + 32 * ks), bf, a0, 0, 0, 0);
            a1 = __builtin_amdgcn_mfma_f32_16x16x32_bf16(*(const GAS bf16x8*)(ap1 + 32 * ks), bf, a1, 0, 0, 0); }
        float lv[8]; int taken = 0;
#pragma unroll
        for (int r = 0; r < 4; ++r) { lv[r] = a0[r] + brt[4 * q + r]; lv[4 + r] = a1[r] + brt[16 + 4 * q + r]; }
        float tv[4]; int te[4];
#pragma unroll
        for (int k = 0; k < 4; ++k) { float bv = -3.0e38f; int be = 64;
#pragma unroll
            for (int r = 0; r < 8; ++r) { const int e = (r < 4) ? 4 * q + r : 16 + 4 * q + (r - 4); const bool ok = !((taken >> r) & 1) && (lv[r] > bv || (lv[r] == bv && e < be)); bv = ok ? lv[r] : bv; be = ok ? e : be; }
#pragma unroll
            for (int o = 16; o < 64; o <<= 1) { const float ov = __shfl_xor(bv, o); const int oe = __shfl_xor(be, o); const bool tk = (ov > bv) || (ov == bv && oe < be); bv = tk ? ov : bv; be = tk ? oe : be; }
            tv[k] = bv; te[k] = be;
#pragma unroll
            for (int r = 0; r < 8; ++r) { const int e = (r < 4) ? 4 * q + r : 16 + 4 * q + (r - 4); if (e == be) taken |= (1 << r); } }
        const float e1 = __expf(tv[1] - tv[0]), e2 = __expf(tv[2] - tv[0]), e3 = __expf(tv[3] - tv[0]); const float inv = 1.0f / (1.0f + e1 + e2 + e3);
        const float wk = (q == 0 ? 1.0f : q == 1 ? e1 : q == 2 ? e2 : e3) * inv; const int ek = (q == 0 ? te[0] : q == 1 ? te[1] : q == 2 ? te[2] : te[3]);
        const int a = tok * 4 + q;
        const int lpos = __hip_atomic_fetch_add(&hist[ek], 1, __ATOMIC_RELAXED, __HIP_MEMORY_SCOPE_WORKGROUP);
        __syncthreads();
        if (F.tid < 32) hist[32 + F.tid] = (int)__hip_atomic_fetch_add(cnt + F.tid, (unsigned)hist[F.tid], RLX_AGENT);
        __syncthreads();
        list[ek * T + hist[32 + ek] + lpos] = a; topw[a] = wk;
        __syncthreads();
    }
}

__device__ __forceinline__ void final_phase(Frame& F) {
    const int gw = F.vcu * NWAVES + F.wave, NGW = F.G * NWAVES;
    const float* h1 = WSP(float, WS_H); const bf16* yb = WSP(bf16, WS_YB);
    for (int t = gw; t < T; t += NGW) {
        f32x4 v[4]; float s = 0.f;
#pragma unroll
        for (int j = 0; j < 4; ++j) { v[j] = ((const GAS f32x4*)(h1 + (size_t)t * 1024))[F.lane + 64 * j] * DN_ALPHA;
#pragma unroll
            for (int k = 0; k < 4; ++k) { const v2u w = *(const GAS v2u*)(yb + ((size_t)t * 4 + k) * 1024 + 256 * j + 4 * F.lane); v[j] += (f32x4){bflo(w.x), bfhi(w.x), bflo(w.y), bfhi(w.y)}; }
            s += (v[j].x + v[j].y) + (v[j].z + v[j].w); }
        const float mean = wave_sum(s) * (1.f / D); float s2 = 0.f;
#pragma unroll
        for (int j = 0; j < 4; ++j) { v[j] = v[j] - mean; s2 += (v[j].x * v[j].x + v[j].y * v[j].y) + (v[j].z * v[j].z + v[j].w * v[j].w); }
        const float rstd = 1.f / sqrtf(wave_sum(s2) * (1.f / D) + LN_EPS);
#pragma unroll
        for (int j = 0; j < 4; ++j) { const f32x4 gg = ((const GAS f32x4*)F.in[27])[F.lane + 64 * j], bb = ((const GAS f32x4*)F.in[28])[F.lane + 64 * j];
            ((GAS f32x4*)(F.out + (size_t)t * 1024))[F.lane + 64 * j] = v[j] * rstd * gg + bb; }
    }
}

struct Args { const float* in[29]; float* out; unsigned char* ws; int ph_lo, ph_hi, li, pad; };
__global__ void __launch_bounds__(NWAVES * 64, 2) mega_fwd(Args args) {
    extern __shared__ __attribute__((aligned(16))) unsigned char lds[];
    Frame F;
    F.lds = (LAS unsigned char*)lds;
    F.tid = threadIdx.x; F.lane = F.tid & 63; F.wave = __builtin_amdgcn_readfirstlane(F.tid >> 6);
    F.G = gridDim.x; { const int bx = blockIdx.x; F.vcu = (F.G % 8 == 0) ? (bx % 8) * (F.G / 8) + bx / 8 : bx; }
#pragma unroll
    for (int i = 0; i < 29; ++i) F.in[i] = args.in[i];
    F.out = args.out; F.ws = args.ws;
    volatile LAS unsigned* MISC = (volatile LAS unsigned*)(F.lds + MISC_OFF);
    for (int u = F.tid; u < (LDS_BYTES - LDSCTL_OFF) / 4; u += NWAVES * 64) ((LAS unsigned*)(F.lds + LDSCTL_OFF))[u] = 0u;
    __syncthreads();
    unsigned* ctl = (unsigned*)(F.ws + WS_CTL);
    XcdBarrier bar; bar.bar = ctl + CW_BAR; bar.x = 0; bar.st = nullptr;
#if !MK_PER_PHASE
    bar = xcd_barrier_post(ctl + CW_BAR, MISC + 8);
#define GRID_BAR() xcd_barrier(bar)
#else
#define GRID_BAR() do {} while (0)
#endif
    const int lo = args.ph_lo, hi = args.ph_hi;
#ifndef PH_MASK
#define PH_MASK 0xfff
#endif
#define IN(k) (((PH_MASK >> (k)) & 1) && lo <= (k) && (k) < hi)
#define BOTH(k) (IN(k) && IN((k) + 1))
#ifndef DUP_MASK
#define DUP_MASK 0
#endif
#define REP(k) _Pragma("unroll") for (int rep_ = 0; rep_ < ((((DUP_MASK) >> (k)) & 1) + 1); ++rep_)
    const int bx = (int)blockIdx.x;

    if (IN(0)) { REP(0) { p0_prologue(F); } if (BOTH(0)) GRID_BAR(); }

    if (IN(1)) { REP(1) {
        { pg8::Gemm g{WSP(bf16, WS_HB), WSP(bf16, WS_WIN), D, D, D}; pg8::StaticOrder S; S.init(T, NP, F.G, bx, D, D);
          EpiBias E{WSP(bf16, WS_PROJ), NP, WSP(float, WS_BIN)}; pg8::gemm_phase(F.lds, g, S, E); }
        { pg8::Gemm g{WSP(bf16, WS_WZ), WSP(bf16, WS_HB), D, D, D}; pg8::StaticOrder S; S.init(1024, T, F.G, bx, D, D);
          EpiZT E{WSP(bf16, WS_ZT), WSP(float, WS_BZ)}; pg8::gemm_phase(F.lds, g, S, E); }
        { pg8::Gemm g{WSP(bf16, WS_MEMN), WSP(bf16, WS_WKV), D, D, D}; pg8::StaticOrder S; S.init(NB * MEM, 512, F.G, F.G - 1 - bx, D, D);
          EpiBias E{WSP(bf16, WS_KV), 512, nullptr}; pg8::gemm_phase(F.lds, g, S, E); }
        { pg8::Gemm g{WSP(bf16, WS_WKV) + 512 * 1024, WSP(bf16, WS_MEMN), D, D, D}; pg8::StaticOrder S; S.init(512, NB * MEM, F.G, F.G - 9 - bx, D, D);
          EpiBias E{WSP(bf16, WS_KV) + 1024 * 512, 1024, nullptr}; pg8::gemm_phase(F.lds, g, S, E); }
        }
        if (BOTH(1)) GRID_BAR();
    }

    if (IN(2)) {
        REP(2) { gla_g1(F);
        xattn_mfma(F);
        fnet_fft(F); }
        if (BOTH(2)) GRID_BAR();
    }

    if (IN(3)) { REP(3) {
        if (bx < 64) gla_g2(F, bx);
        else moe_weight_cvt(F, (bx - 64) * NWAVES + F.wave, (F.G - 64) * NWAVES);
        }
        if (BOTH(3)) GRID_BAR();
    }

    if (IN(4)) { REP(4) { gla_finalize(F); } if (BOTH(4)) GRID_BAR(); }

    if (IN(5)) { REP(5) {
        const bf16* gate = WSP(bf16, WS_PROJ) + G_OFF;
        { pg8::Gemm g{WSP(bf16, WS_OG), WSP(bf16, WS_WGLA), 1024, 1024, 1024}; pg8::StaticOrder S; S.init(T, D, F.G, bx, 1024, 1024);
          EpiGate<0> E{WSP(float, WS_MG), WSP(bf16, WS_MGB), gate}; pg8::gemm_phase(F.lds, g, S, E); }
        { pg8::Gemm g{WSP(bf16, WS_F), WSP(bf16, WS_WFN), 512, 512, 512}; pg8::StaticOrder S; S.init(T, D, F.G, bx, 512, 512);
          EpiGate<1> E{WSP(float, WS_MG), WSP(bf16, WS_MGB), gate + 1024}; pg8::gemm_phase(F.lds, g, S, E); }
        { pg8::Gemm g{WSP(bf16, WS_OM), WSP(bf16, WS_WMEM), 512, 512, 512}; pg8::StaticOrder S; S.init(T, D, F.G, bx, 512, 512);
          EpiGate<2> E{WSP(float, WS_MG), WSP(bf16, WS_MGB), gate + 2048}; pg8::gemm_phase(F.lds, g, S, E); }
        }
        if (BOTH(5)) GRID_BAR();
    }

    if (IN(6)) {
        pg8::Gemm g{WSP(bf16, WS_MGB), WSP(bf16, WS_WOUT), 1024, 1024, 1024}; pg8::StaticOrder S; S.init(T, D, F.G, bx, 1024, 1024);
        EpiOut E{WSP(float, WS_H), F.in[18]}; pg8::gemm_phase(F.lds, g, S, E);
        if (BOTH(6)) GRID_BAR();
    }

    if (IN(7)) {
        const int gw = F.vcu * NWAVES + F.wave, NGW = F.G * NWAVES;
        for (int m = gw; m < T; m += NGW) ln_row(WSP(float, WS_H) + (size_t)m * D, F.in[19], F.in[20], WSP(float, WS_H) + (size_t)m * D, WSP(bf16, WS_HB) + (size_t)m * D, F.lane, 1.0f);
        if (BOTH(7)) GRID_BAR();
    }

    if (IN(8)) { router_phase(F); if (BOTH(8)) GRID_BAR(); }

    if (IN(9) || IN(10)) {
        volatile LAS int* tb = (volatile LAS int*)(F.lds + MISC_OFF + 256);
        __syncthreads();
        if (F.tid == 0) { const unsigned* cnt = ctl + CW_CNT; int acc = 0;
            for (int e = 0; e < 32; ++e) { const int c = (int)__hip_atomic_load(cnt + e, RLX_AGENT); tb[e] = c; tb[32 + e] = acc; acc += (c + 255) >> 8; }
            tb[64] = acc; }
        __syncthreads();
        if (IN(9)) { REP(9) {
            MoeSched<8, true> S; S.tb = tb; S.list = WSP(int, WS_RT); S.G = F.G; S.c = bx; S.lda = 1024; S.ldb = 1024; S.bstride = (size_t)2048 * 1024 * 2;
            pg8::Gemm g{WSP(bf16, WS_HB), WSP(bf16, WS_WGU), 1024, 1024, 1024};
            EpiSwiglu E{WSP(bf16, WS_ACT), WSP(float, WS_BGU), S}; pg8::gemm_phase(F.lds, g, S, E); }
            if (BOTH(9)) GRID_BAR();
        }
        if (IN(10)) { REP(10) {
            MoeSched<4, false> S; S.tb = tb; S.list = WSP(int, WS_RT); S.G = F.G; S.c = bx; S.lda = 1024; S.ldb = 1024; S.bstride = (size_t)1024 * 1024 * 2;
            pg8::Gemm g{WSP(bf16, WS_ACT), WSP(bf16, WS_WDN), 1024, 1024, 1024};
            EpiDown E{WSP(bf16, WS_YB), F.in[26], WSP(float, WS_TOPW), WSP(int, WS_RT), S}; pg8::gemm_phase(F.lds, g, S, E); }
            if (BOTH(10)) GRID_BAR();
        }
    }

    if (IN(11)) { REP(11) { final_phase(F); } }
#undef IN
#undef BOTH
}

extern "C" void kernel_launch(void* const* d_in, const int* in_sizes, int n_in, void* d_out, int out_size, void* d_ws, size_t ws_size, hipStream_t stream) {
    static int grid = 0;
    if (grid == 0) {
        if (n_in != 29 || out_size != T * D || ws_size < WS_END) { fprintf(stderr, "kernel_launch: unexpected shapes (n_in %d out %d ws %zu need %zu)\n", n_in, out_size, ws_size, (size_t)WS_END); grid = -1; return; }
        int dev = 0, cus = 0, per_cu = 0;
        if (hipGetDevice(&dev) != hipSuccess || hipDeviceGetAttribute(&cus, hipDeviceAttributeMultiprocessorCount, dev) != hipSuccess) { grid = -1; return; }
        if (hipFuncSetAttribute((const void*)mega_fwd, hipFuncAttributeMaxDynamicSharedMemorySize, LDS_BYTES) != hipSuccess) { fprintf(stderr, "kernel_launch: hipFuncSetAttribute failed\n"); grid = -1; return; }
        if (hipOccupancyMaxActiveBlocksPerMultiprocessor(&per_cu, (const void*)mega_fwd, NWAVES * 64, LDS_BYTES) != hipSuccess || per_cu < 1) fprintf(stderr, "kernel_launch: occupancy query says %d\n", per_cu);
        (void)hipGetLastError();
        grid = cus;
    }
    if (grid < 0) return;
    (void)in_sizes;
    if (hipMemsetAsync((char*)d_ws + WS_CTL, 0, CTL_ZERO_BYTES, stream) != hipSuccess) return;
    Args a{};
    for (int i = 0; i < 29; ++i) a.in[i] = (const float*)d_in[i];
    a.out = (float*)d_out; a.ws = (unsigned char*)d_ws;
#if MK_PER_PHASE
    for (int p = 0; p < N_PHASES; ++p) { a.ph_lo = p; a.ph_hi = p + 1; a.li = p; hipLaunchKernelGGL(mega_fwd, dim3(grid), dim3(NWAVES * 64), LDS_BYTES, stream, a); }
#else
    a.ph_lo = 0; a.ph_hi = N_PHASES; a.li = 0;
    hipLaunchKernelGGL(mega_fwd, dim3(grid), dim3(NWAVES * 64), LDS_BYTES, stream, a);
#endif
}
```
